# Optimizing an MI355X kernel written in HIP

```python
import jax, jax.numpy as jnp
from jax import lax
import numpy as np

D_MODEL = 1024
BATCH = 2
SEQ = 8192
DEPTH = 2

PLE_DIM = 256
N_A_LAYERS = DEPTH // 2
N_B_LAYERS = DEPTH - N_A_LAYERS
N_HEADS = 16
HEAD_DIM = 64
ROPE_DIM = HEAD_DIM // 4
ROPE_THETA = 500000.0
Q_BLOCK = 128
NSA_GROUPS = 4
HEADS_PER_GROUP = N_HEADS // NSA_GROUPS
CMP_BLOCK = 32
CMP_STRIDE = 16
CMP_HIDDEN = 256
SEL_BLOCK = 64
SEL_TOPK = 16
WINDOW = 512
N_EXPERTS = 32
TOP_K = 4
D_EXPERT = D_MODEL
SWIGLU_LIMIT = 7.0
SWIGLU_ALPHA = 1.702
MOE_BLOCK = 256
EPS = 1e-6
NEG = -1e30
FORCE = 1e6

kernel_name = "yoco_fox_nsa_moe_ple"


def rmsnorm(x, g):
    xf = x.astype(jnp.float32)
    y = xf * lax.rsqrt(jnp.mean(xf * xf, axis=-1, keepdims=True) + EPS)
    return (y * g.astype(jnp.float32)).astype(x.dtype)


def rope_partial(x, pos):
    inv = jnp.power(jnp.float32(ROPE_THETA), -jnp.arange(0, ROPE_DIM, 2, dtype=jnp.float32) / ROPE_DIM)
    ang = pos.astype(jnp.float32)[:, None] * inv[None, :]
    cos, sin = jnp.cos(ang), jnp.sin(ang)
    xr = x[..., :ROPE_DIM].astype(jnp.float32)
    half = ROPE_DIM // 2
    x1, x2 = xr[..., :half], xr[..., half:]
    rot = jnp.concatenate([x1 * cos - x2 * sin, x2 * cos + x1 * sin], axis=-1)
    return jnp.concatenate([rot.astype(x.dtype), x[..., ROPE_DIM:]], axis=-1)


def fox_attention(h, w_in, b_f, qk_gain, w_out):
    B, T, _ = h.shape
    hd = N_HEADS * HEAD_DIM
    proj = h @ w_in
    to_heads = lambda z: z.reshape(B, T, N_HEADS, HEAD_DIM).transpose(0, 2, 1, 3)
    q = rmsnorm(to_heads(proj[..., :hd]), qk_gain[0])
    k = rmsnorm(to_heads(proj[..., hd:2 * hd]), qk_gain[1])
    v = to_heads(proj[..., 2 * hd:3 * hd])
    logf = jax.nn.log_sigmoid(proj[..., 3 * hd:].astype(jnp.float32) + b_f.astype(jnp.float32))
    c = jnp.cumsum(logf, axis=1).transpose(0, 2, 1)
    n_blk = T // Q_BLOCK
    qb = q.reshape(B, N_HEADS, n_blk, Q_BLOCK, HEAD_DIM).transpose(2, 0, 1, 3, 4)
    cb = c.reshape(B, N_HEADS, n_blk, Q_BLOCK).transpose(2, 0, 1, 3)
    pb = jnp.arange(T).reshape(n_blk, Q_BLOCK)
    k_pos = jnp.arange(T)
    scale = HEAD_DIM ** -0.5

    def block(args):
        qi, ci, ti = args
        s = jnp.einsum('bhqd,bhkd->bhqk', qi, k).astype(jnp.float32) * scale
        s = s + ci[..., None] - c[:, :, None, :]
        s = jnp.where(k_pos[None, :] <= ti[:, None], s, NEG)
        pr = jax.nn.softmax(s, axis=-1)
        return jnp.einsum('bhqk,bhkd->bhqd', pr.astype(v.dtype), v)

    o = lax.map(block, (qb, cb, pb))
    o = o.transpose(1, 0, 3, 2, 4).reshape(B, T, hd)
    return o @ w_out


def nsa_shared_kv(x, kv_norm, kv_w, kv_k_gain, cmp_pos, cmp_w1, cmp_w2):
    B, T, _ = x.shape
    h = rmsnorm(x, kv_norm)
    kv = (h @ kv_w).reshape(B, T, 6, NSA_GROUPS, HEAD_DIM).transpose(2, 0, 3, 1, 4)
    pos = jnp.arange(T)
    n_cmp = (T - CMP_BLOCK) // CMP_STRIDE + 1
    idx = jnp.arange(n_cmp)[:, None] * CMP_STRIDE + jnp.arange(CMP_BLOCK)[None, :]

    def compress(z, j):
        blocks = z[:, :, idx] + cmp_pos[j]
        flat = blocks.reshape(B, NSA_GROUPS, n_cmp, CMP_BLOCK * HEAD_DIM)
        return jax.nn.silu(flat @ cmp_w1[j]) @ cmp_w2[j]

    cmp_end = jnp.arange(n_cmp) * CMP_STRIDE + CMP_BLOCK - 1
    kc = rope_partial(rmsnorm(compress(kv[0], 0), kv_k_gain[0]), cmp_end)
    vc = compress(kv[1], 1)
    ks = rope_partial(rmsnorm(kv[2], kv_k_gain[1]), pos)
    kw = rope_partial(rmsnorm(kv[4], kv_k_gain[2]), pos)
    n_sel = T // SEL_BLOCK
    ks_b = ks.reshape(B, NSA_GROUPS, n_sel, SEL_BLOCK, HEAD_DIM)
    vs_b = kv[3].reshape(B, NSA_GROUPS, n_sel, SEL_BLOCK, HEAD_DIM)
    pad = ((0, 0), (0, 0), (WINDOW, 0), (0, 0))
    return kc, vc, ks_b, vs_b, jnp.pad(kw, pad), jnp.pad(kv[5], pad)


def nsa_attention(h, w_in, q_gain, w_out, kc, vc, ks_b, vs_b, kw_p, vw_p):
    B, T, _ = h.shape
    G, M = NSA_GROUPS, HEADS_PER_GROUP
    hd = N_HEADS * HEAD_DIM
    proj = h @ w_in
    pos = jnp.arange(T)
    q = proj[..., :hd].reshape(B, T, N_HEADS, HEAD_DIM).transpose(0, 2, 1, 3)
    q = rope_partial(rmsnorm(q, q_gain), pos).reshape(B, G, M, T, HEAD_DIM)
    gates = jax.nn.sigmoid(proj[..., hd:].astype(jnp.float32)).reshape(B, T, 3, G, M).transpose(2, 0, 3, 4, 1)
    n_blk = T // Q_BLOCK
    q_blocks = q.reshape(B, G, M, n_blk, Q_BLOCK, HEAD_DIM).transpose(3, 0, 1, 2, 4, 5)
    g_blocks = gates.reshape(3, B, G, M, n_blk, Q_BLOCK).transpose(4, 0, 1, 2, 3, 5)
    n_cmp = kc.shape[2]
    n_sel = ks_b.shape[2]
    n_top = min(SEL_TOPK, n_sel)
    cmp_start = jnp.arange(n_cmp) * CMP_STRIDE
    cmp_end = cmp_start + CMP_BLOCK - 1
    sel_start = jnp.arange(n_sel) * SEL_BLOCK
    overlap = jnp.clip(jnp.minimum(cmp_start[:, None] + CMP_BLOCK, sel_start[None, :] + SEL_BLOCK)
                       - jnp.maximum(cmp_start[:, None], sel_start[None, :]), 0).astype(jnp.float32)
    b_ix = jnp.arange(B)[:, None, None, None]
    g_ix = jnp.arange(G)[None, :, None, None]
    j_ix = jnp.arange(n_sel)
    scale = HEAD_DIM ** -0.5

    def block(args):
        qi, gi, bi = args
        q0 = bi * Q_BLOCK
        tq = q0 + jnp.arange(Q_BLOCK)
        s = jnp.einsum('bgmqd,bgnd->bgmqn', qi, kc).astype(jnp.float32) * scale
        valid_c = cmp_end[None, :] <= tq[:, None]
        p_c = jax.nn.softmax(jnp.where(valid_c, s, NEG), axis=-1) * valid_c
        o_c = jnp.einsum('bgmqn,bgnd->bgmqd', p_c.astype(vc.dtype), vc)
        imp = jnp.einsum('bgmqn,nj->bgqj', p_c, overlap)
        cur = tq // SEL_BLOCK
        forced = (j_ix[None, :] == 0) | (j_ix[None, :] == cur[:, None]) | (j_ix[None, :] == cur[:, None] - 1)
        causal_j = sel_start[None, :] <= tq[:, None]
        score = jnp.where(causal_j, jnp.where(forced, FORCE, imp), -jnp.inf)
        top_s, top_j = lax.top_k(score, n_top)
        ks = ks_b[b_ix, g_ix, top_j].reshape(B, G, Q_BLOCK, n_top * SEL_BLOCK, HEAD_DIM)
        vs = vs_b[b_ix, g_ix, top_j].reshape(B, G, Q_BLOCK, n_top * SEL_BLOCK, HEAD_DIM)
        kpos = top_j[..., None] * SEL_BLOCK + jnp.arange(SEL_BLOCK)
        mask_s = (jnp.isfinite(top_s)[..., None] & (kpos <= tq[:, None, None])).reshape(B, G, Q_BLOCK, n_top * SEL_BLOCK)
        s = jnp.einsum('bgmqd,bgqkd->bgmqk', qi, ks).astype(jnp.float32) * scale
        p_s = jax.nn.softmax(jnp.where(mask_s[:, :, None], s, NEG), axis=-1)
        o_s = jnp.einsum('bgmqk,bgqkd->bgmqd', p_s.astype(vs.dtype), vs)
        kw = lax.dynamic_slice_in_dim(kw_p, q0, Q_BLOCK + WINDOW, axis=2)
        vw = lax.dynamic_slice_in_dim(vw_p, q0, Q_BLOCK + WINDOW, axis=2)
        wpos = q0 - WINDOW + jnp.arange(Q_BLOCK + WINDOW)
        mask_w = (wpos[None, :] <= tq[:, None]) & (wpos[None, :] > tq[:, None] - WINDOW) & (wpos[None, :] >= 0)
        s = jnp.einsum('bgmqd,bgkd->bgmqk', qi, kw).astype(jnp.float32) * scale
        p_w = jax.nn.softmax(jnp.where(mask_w, s, NEG), axis=-1)
        o_w = jnp.einsum('bgmqk,bgkd->bgmqd', p_w.astype(vw.dtype), vw)
        o = gi[0][..., None] * o_c + gi[1][..., None] * o_s + gi[2][..., None] * o_w
        return o.astype(qi.dtype)

    o = lax.map(block, (q_blocks, g_blocks, jnp.arange(n_blk)))
    o = o.transpose(1, 0, 4, 2, 3, 5).reshape(B, T, hd)
    return o @ w_out


def moe_ffn(h, router_w, router_b, w_gu, b_gu, w_down, b_down):
    B, T, D = h.shape
    xt = h.reshape(B * T, D)
    n_assign = B * T * TOP_K
    logits = (xt @ router_w).astype(jnp.float32) + router_b.astype(jnp.float32)
    top_val, top_idx = lax.top_k(logits, TOP_K)
    gate = jax.nn.softmax(top_val, axis=-1)
    flat_e = top_idx.reshape(-1)
    flat_tok = jnp.arange(n_assign) // TOP_K
    order = jnp.argsort(flat_e)
    se, stok, sg = flat_e[order], flat_tok[order], gate.reshape(-1)[order]
    counts = jnp.bincount(flat_e, length=N_EXPERTS)
    padded = (counts + MOE_BLOCK - 1) // MOE_BLOCK * MOE_BLOCK
    start = jnp.cumsum(counts) - counts
    pend = jnp.cumsum(padded)
    pstart = pend - padded
    dest = pstart[se] + jnp.arange(n_assign) - start[se]
    n_blocks = -(-n_assign // MOE_BLOCK) + N_EXPERTS
    cap = n_blocks * MOE_BLOCK
    buf_tok = jnp.zeros((cap,), jnp.int32).at[dest].set(stok)
    buf_g = jnp.zeros((cap,), jnp.float32).at[dest].set(sg)
    blk_exp = jnp.minimum(jnp.searchsorted(pend, jnp.arange(n_blocks) * MOE_BLOCK, side='right'), N_EXPERTS - 1)

    def run_block(args):
        tok, g, e = args
        xb = xt[tok]
        gu = xb @ w_gu[e] + b_gu[e]
        a, u = gu[:, :D_EXPERT], gu[:, D_EXPERT:]
        a = jnp.minimum(a, SWIGLU_LIMIT)
        u = jnp.clip(u, -SWIGLU_LIMIT, SWIGLU_LIMIT)
        y = (u + 1) * (a * jax.nn.sigmoid(SWIGLU_ALPHA * a))
        out = y @ w_down[e] + b_down[e]
        return (out * g[:, None]).astype(xt.dtype)

    outs = lax.map(run_block, (buf_tok.reshape(n_blocks, MOE_BLOCK), buf_g.reshape(n_blocks, MOE_BLOCK), blk_exp))
    y = jnp.zeros_like(xt).at[buf_tok].add(outs.reshape(cap, D))
    return y.reshape(B, T, D)


def setup_inputs(seed: int = 0) -> dict:
    key = jax.random.key(seed)
    keys = iter(jax.random.split(key, 40))

    def nrm(shape, scale):
        return jax.random.normal(next(keys), shape, jnp.float32) * scale

    def gain(shape):
        return 1.0 + 0.05 * jax.random.normal(next(keys), shape, jnp.float32)

    D, H, hd = D_MODEL, N_HEADS, HEAD_DIM
    F, E = D_EXPERT, N_EXPERTS
    return {
        "x": nrm((BATCH, SEQ, D), 1.0),
        "p": nrm((DEPTH, BATCH, SEQ, PLE_DIM), 1.0),
        "attn_norm": gain((DEPTH, D)),
        "ffn_norm": gain((DEPTH, D)),
        "ple_norm": gain((DEPTH, D)),
        "ple_gate_w": nrm((DEPTH, D, D), D ** -0.5),
        "ple_proj_w": nrm((DEPTH, PLE_DIM, D), PLE_DIM ** -0.5),
        "router_w": nrm((DEPTH, D, E), D ** -0.5),
        "router_b": nrm((DEPTH, E), 0.01),
        "w_gu": nrm((DEPTH, E, D, 2 * F), D ** -0.5),
        "b_gu": nrm((DEPTH, E, 2 * F), 0.02),
        "w_down": nrm((DEPTH, E, F, D), F ** -0.5),
        "b_down": nrm((DEPTH, E, D), 0.02),
        "fox_w_in": nrm((N_A_LAYERS, D, 3 * H * hd + H), D ** -0.5),
        "fox_b_f": 2.0 + nrm((N_A_LAYERS, H), 0.5),
        "fox_qk_gain": gain((N_A_LAYERS, 2, hd)),
        "fox_w_out": nrm((N_A_LAYERS, H * hd, D), (H * hd) ** -0.5),
        "kv_norm": gain((D,)),
        "kv_w": nrm((D, 6 * NSA_GROUPS * hd), D ** -0.5),
        "kv_k_gain": gain((3, hd)),
        "cmp_pos": nrm((2, CMP_BLOCK, hd), 0.5),
        "cmp_w1": nrm((2, CMP_BLOCK * hd, CMP_HIDDEN), (CMP_BLOCK * hd) ** -0.5),
        "cmp_w2": nrm((2, CMP_HIDDEN, hd), CMP_HIDDEN ** -0.5),
        "nsa_w_in": nrm((N_B_LAYERS, D, H * hd + 3 * H), D ** -0.5),
        "nsa_q_gain": gain((N_B_LAYERS, hd)),
        "nsa_w_out": nrm((N_B_LAYERS, H * hd, D), (H * hd) ** -0.5),
    }


def reference(x, p, attn_norm, ffn_norm, ple_norm, ple_gate_w, ple_proj_w, router_w, router_b, w_gu, b_gu, w_down, b_down, fox_w_in, fox_b_f, fox_qk_gain, fox_w_out, kv_norm, kv_w, kv_k_gain, cmp_pos, cmp_w1, cmp_w2, nsa_w_in, nsa_q_gain, nsa_w_out):
    shared = None
    for layer in range(DEPTH):
        if layer == N_A_LAYERS:
            shared = nsa_shared_kv(x, kv_norm, kv_w, kv_k_gain, cmp_pos, cmp_w1, cmp_w2)
        h = rmsnorm(x, attn_norm[layer])
        if layer < N_A_LAYERS:
            x = x + fox_attention(h, fox_w_in[layer], fox_b_f[layer], fox_qk_gain[layer], fox_w_out[layer])
        else:
            i = layer - N_A_LAYERS
            x = x + nsa_attention(h, nsa_w_in[i], nsa_q_gain[i], nsa_w_out[i], *shared)
        x = x + moe_ffn(rmsnorm(x, ffn_norm[layer]), router_w[layer], router_b[layer], w_gu[layer], b_gu[layer], w_down[layer], b_down[layer])
        gate = jax.nn.sigmoid(rmsnorm(x, ple_norm[layer]) @ ple_gate_w[layer])
        x = x + gate * (p[layer] @ ple_proj_w[layer])
    return x
```

```cpp
#include <hip/hip_runtime.h>
#include <hip/hip_cooperative_groups.h>
#include <cstdint>
#include <cstdio>
namespace cg = cooperative_groups;

#ifndef REPEAT_MASK
#define REPEAT_MASK 0u
#endif
#ifndef N_LAUNCH_MODE
#define N_LAUNCH_MODE 1
#endif

#define LAS __attribute__((address_space(3)))
typedef unsigned short bf16_t;
typedef short bf16x8 __attribute__((ext_vector_type(8)));
typedef short s16x4 __attribute__((ext_vector_type(4)));
typedef float f32x2 __attribute__((ext_vector_type(2)));
typedef float f32x4 __attribute__((ext_vector_type(4)));
typedef float f32x16 __attribute__((ext_vector_type(16)));
typedef unsigned u32x2 __attribute__((ext_vector_type(2)));
typedef unsigned u32x4 __attribute__((ext_vector_type(4)));
typedef int i32x8 __attribute__((ext_vector_type(8)));
typedef int i32x4 __attribute__((ext_vector_type(4)));

constexpr int NB = 2, T = 8192, D = 1024, M = NB * T, NH = 16, HD = 64, NG = 4, HPG = 4;
constexpr int PLE = 256, NE = 32, TOPK = 4, FF = 1024;
constexpr int NCMP = 511, NSEL = 128, SELTOP = 16, WIN = 512;
constexpr int FOXN = 3 * NH * HD + NH;
constexpr int NSAN = NH * HD + 3 * NH;
constexpr int KVN = 6 * NG * HD;
constexpr float EPS = 1e-6f;
constexpr float LOG2E = 1.4426950408889634f;
constexpr float C2 = 0.125f * LOG2E;
constexpr int MOE_ROWS = M * TOPK + NE * 256;
constexpr int NWAVES = 8, NTHREADS = 512;

constexpr size_t MiB = 1u << 20;
constexpr size_t al(size_t x) { return (x + 4095) & ~(size_t)4095; }
constexpr size_t WS_CTL = 0, CTL_BYTES = 1 * MiB;
constexpr size_t WS_ROPE = WS_CTL + CTL_BYTES;
constexpr size_t WS_WFT = WS_ROPE + (size_t)T * 8 * 2 * 4;
constexpr size_t WS_WRT = WS_WFT + 32 * 1024 * 4;
constexpr size_t WS_WGT = WS_WRT + 2 * 32 * 1024 * 4;
constexpr size_t WS_CB1 = WS_WGT + 64 * 1024 * 4;
constexpr size_t WS_RSTD = al(WS_CB1 + 2 * 256 * 4);
constexpr size_t WS_LOGF = WS_RSTD + (size_t)M * 4;
constexpr size_t WS_BIAS = WS_LOGF + (size_t)NB * NH * T * 4;
constexpr size_t WS_KAUG = WS_BIAS + (size_t)NB * NH * T * 4;
constexpr size_t WS_GATES = WS_KAUG + (size_t)NB * NH * T * 16;
constexpr size_t WS_TOKINFO = WS_GATES + (size_t)M * 48 * 4;
constexpr size_t WS_LIST = WS_TOKINFO + (size_t)M * 4 * 4;
constexpr size_t WS_GL = WS_LIST + (size_t)NE * M * 4;
constexpr size_t WS_WFOXIN = al(WS_GL + (size_t)NE * M * 4);
constexpr size_t WS_WFOXOUT = WS_WFOXIN + (size_t)3072 * 1024 * 2;
constexpr size_t WS_WNSA = WS_WFOXOUT + (size_t)1024 * 1024 * 2;
constexpr size_t WS_WNSAOUT = WS_WNSA + (size_t)2560 * 1024 * 2;
constexpr size_t WS_WPLEG = WS_WNSAOUT + (size_t)1024 * 1024 * 2;
constexpr size_t WS_WPLEP = WS_WPLEG + (size_t)2 * 1024 * 1024 * 2;
constexpr size_t WS_WC1 = WS_WPLEP + (size_t)2 * 1024 * 256 * 2;
constexpr size_t WS_WC2 = WS_WC1 + (size_t)2 * 256 * 2048 * 2;
constexpr size_t WS_WGU = al(WS_WC2 + (size_t)2 * 64 * 256 * 2);
constexpr size_t WS_WDN = WS_WGU + (size_t)2 * 32 * 2048 * 1024 * 2;
constexpr size_t WS_XB = WS_WDN + (size_t)2 * 32 * 1024 * 1024 * 2;
constexpr size_t WS_XN = WS_XB + (size_t)M * D * 4;
constexpr size_t WS_Q = WS_XN + (size_t)M * D * 2;
constexpr size_t WS_K = WS_Q + (size_t)M * D * 2;
constexpr size_t WS_V = WS_K + (size_t)M * D * 2;
constexpr size_t WS_O = WS_V + (size_t)M * D * 2;
constexpr size_t NSA_HEADBUF = (size_t)NB * NG * T * HD * 2;
constexpr size_t KV6_STRIDE = NSA_HEADBUF + 8192;
constexpr size_t WS_ZK = WS_O + (size_t)M * D * 2;
constexpr size_t WS_ZV = WS_ZK + KV6_STRIDE;
constexpr size_t WS_KS = WS_ZV + KV6_STRIDE;
constexpr size_t WS_VS = WS_KS + KV6_STRIDE;
constexpr size_t WS_KW = WS_VS + KV6_STRIDE;
constexpr size_t WS_VW = WS_KW + KV6_STRIDE;
constexpr size_t WS_KC = WS_VW + KV6_STRIDE;
constexpr size_t WS_VC = WS_KC + (size_t)8 * 512 * 64 * 2;
constexpr size_t WS_PBF = WS_VC + (size_t)8 * 512 * 64 * 2;
constexpr size_t WS_PP = WS_PBF + (size_t)2 * M * PLE * 2;
constexpr size_t WS_H = WS_PP + (size_t)2 * M * D * 2;
constexpr size_t WS_Y = WS_H + (size_t)MOE_ROWS * FF * 2;
constexpr size_t WS_XN8 = WS_Y + (size_t)MOE_ROWS * D * 2;
constexpr size_t WS_END = WS_XN8 + (size_t)M * D;

constexpr int CW_CNT = 16384, CNT_STRIDE = 64;
constexpr int CW_BAR = 4096;

constexpr int RING_BYTES = 131072;
constexpr int LDS_BYTES = 147456;
constexpr int LDS_MISC = LDS_BYTES - 2048;

__device__ __forceinline__ unsigned f2bf(float f) { unsigned u = __builtin_bit_cast(unsigned, f); return (u + 0x7fffu + ((u >> 16) & 1u)) >> 16; }
typedef __bf16 bf16x2_t __attribute__((ext_vector_type(2)));
__device__ __forceinline__ unsigned pk2(float lo, float hi) { f32x2 v = {lo, hi}; bf16x2_t b = __builtin_convertvector(v, bf16x2_t); return __builtin_bit_cast(unsigned, b); }
__device__ __forceinline__ unsigned pk4_fp8(float a, float b, float c, float d) { int w = __builtin_amdgcn_cvt_pk_fp8_f32(a, b, 0, false); w = __builtin_amdgcn_cvt_pk_fp8_f32(c, d, w, true); return (unsigned)w; }
constexpr float W8_SCALE = 32.f, W8_INV = 1.f / 32.f, Y8_SCALE = 16.f, Y8_INV = 1.f / 16.f;
__device__ __forceinline__ f32x4 ld4(const float* p) { return *(const f32x4*)p; }
__device__ __forceinline__ f32x4 ld4(const bf16_t* p) { const u32x2 w = *(const u32x2*)p; return (f32x4){__builtin_bit_cast(float, w.x << 16), __builtin_bit_cast(float, w.x & 0xffff0000u), __builtin_bit_cast(float, w.y << 16), __builtin_bit_cast(float, w.y & 0xffff0000u)}; }
__device__ __forceinline__ void ld8(const float* p, f32x4& a, f32x4& b) { a = *(const f32x4*)p; b = *(const f32x4*)(p + 4); }
__device__ __forceinline__ void ld8(const bf16_t* p, f32x4& a, f32x4& b) { const u32x4 w = *(const u32x4*)p;
    a = (f32x4){__builtin_bit_cast(float, w.x << 16), __builtin_bit_cast(float, w.x & 0xffff0000u), __builtin_bit_cast(float, w.y << 16), __builtin_bit_cast(float, w.y & 0xffff0000u)};
    b = (f32x4){__builtin_bit_cast(float, w.z << 16), __builtin_bit_cast(float, w.z & 0xffff0000u), __builtin_bit_cast(float, w.w << 16), __builtin_bit_cast(float, w.w & 0xffff0000u)}; }
__device__ __forceinline__ void st8(float* p, const f32x4 a, const f32x4 b) { *(f32x4*)p = a; *(f32x4*)(p + 4) = b; }
__device__ __forceinline__ void st4(float* p, const f32x4 v) { *(f32x4*)p = v; }
__device__ __forceinline__ void st4(bf16_t* p, const f32x4 v) { u32x2 o; o.x = pk2(v[0], v[1]); o.y = pk2(v[2], v[3]); *(u32x2*)p = o; }
__device__ __forceinline__ float bf2f(unsigned short b) { return __builtin_bit_cast(float, (unsigned)b << 16); }
#define DPPF(v, ctrl, rm) __uint_as_float(__builtin_amdgcn_update_dpp(0u, __float_as_uint(v), ctrl, rm, 0xF, true))
__device__ __forceinline__ float wave_sum(float v) {
    v += DPPF(v, 0xB1, 0xF); v += DPPF(v, 0x4E, 0xF); v += DPPF(v, 0x141, 0xF); v += DPPF(v, 0x140, 0xF);
    { auto r = __builtin_amdgcn_permlane16_swap(__float_as_uint(v), __float_as_uint(v), false, false); v = __uint_as_float(r[0]) + __uint_as_float(r[1]); }
    { auto r = __builtin_amdgcn_permlane32_swap(__float_as_uint(v), __float_as_uint(v), false, false); v = __uint_as_float(r[0]) + __uint_as_float(r[1]); }
    return v;
}
__device__ __forceinline__ float wave_max(float v) {
    v = fmaxf(v, DPPF(v, 0xB1, 0xF)); v = fmaxf(v, DPPF(v, 0x4E, 0xF)); v = fmaxf(v, DPPF(v, 0x141, 0xF)); v = fmaxf(v, DPPF(v, 0x140, 0xF));
    { auto r = __builtin_amdgcn_permlane16_swap(__float_as_uint(v), __float_as_uint(v), false, false); v = fmaxf(__uint_as_float(r[0]), __uint_as_float(r[1])); }
    { auto r = __builtin_amdgcn_permlane32_swap(__float_as_uint(v), __float_as_uint(v), false, false); v = fmaxf(__uint_as_float(r[0]), __uint_as_float(r[1])); }
    return v;
}
__device__ __forceinline__ float wave_scan_f(float v) {
    v += DPPF(v, 0x111, 0xF); v += DPPF(v, 0x112, 0xF); v += DPPF(v, 0x114, 0xF); v += DPPF(v, 0x118, 0xF);
    v += DPPF(v, 0x142, 0xA); v += DPPF(v, 0x143, 0xC);
    return v;
}
__device__ __forceinline__ f32x16 splat16z() { f32x16 r;
#pragma unroll
    for (int i = 0; i < 16; ++i) r[i] = 0.f; return r; }
__device__ __forceinline__ int lane_id() { return (int)__builtin_amdgcn_mbcnt_hi(~0u, __builtin_amdgcn_mbcnt_lo(~0u, 0u)); }
__device__ __forceinline__ int lane_id_v() { int l; asm volatile("v_mbcnt_lo_u32_b32 %0, -1, 0\n\tv_mbcnt_hi_u32_b32 %0, -1, %0" : "=v"(l)); return l; }
__device__ __forceinline__ float xor32_other(float v) { auto r = __builtin_amdgcn_permlane32_swap(__float_as_uint(v), __float_as_uint(v), false, false); return __uint_as_float(((lane_id() >> 5) & 1) ? r[0] : r[1]); }
__device__ __forceinline__ float xor32_sum(float v) { auto r = __builtin_amdgcn_permlane32_swap(__float_as_uint(v), __float_as_uint(v), false, false); return __uint_as_float(r[0]) + __uint_as_float(r[1]); }
__device__ __forceinline__ float xor16_sum(float v) { auto r = __builtin_amdgcn_permlane16_swap(__float_as_uint(v), __float_as_uint(v), false, false); return __uint_as_float(r[0]) + __uint_as_float(r[1]); }
__device__ __forceinline__ float xor8_sum(float v) { return v + __uint_as_float(__builtin_amdgcn_update_dpp(0u, __float_as_uint(v), 0x128, 0xF, 0xF, true)); }
__device__ __forceinline__ unsigned max8_u32(unsigned v) {
    v = max(v, (unsigned)__builtin_amdgcn_update_dpp(0u, v, 0xB1, 0xF, 0xF, true));
    v = max(v, (unsigned)__builtin_amdgcn_update_dpp(0u, v, 0x4E, 0xF, 0xF, true));
    v = max(v, (unsigned)__builtin_amdgcn_update_dpp(0u, v, 0x141, 0xF, 0xF, true));
    return v;
}
__device__ __forceinline__ float xor16_other(float v) { auto r = __builtin_amdgcn_permlane16_swap(__float_as_uint(v), __float_as_uint(v), false, false); return __uint_as_float(((lane_id() >> 4) & 1) ? r[0] : r[1]); }
#define LDS_WAIT() asm volatile("s_waitcnt lgkmcnt(0)" ::: "memory")
#define VM_WAIT() asm volatile("s_waitcnt vmcnt(0)" ::: "memory")

struct Params {
    const float* x; const float* p; const float* attn_norm; const float* ffn_norm; const float* ple_norm;
    const float* ple_gate_w; const float* ple_proj_w; const float* router_w; const float* router_b;
    const float* w_gu; const float* b_gu; const float* w_down; const float* b_down;
    const float* fox_w_in; const float* fox_b_f; const float* fox_qk_gain; const float* fox_w_out;
    const float* kv_norm; const float* kv_w; const float* kv_k_gain; const float* cmp_pos; const float* cmp_w1; const float* cmp_w2;
    const float* nsa_w_in; const float* nsa_q_gain; const float* nsa_w_out;
    float* out; unsigned char* ws;
    int ph_lo, ph_hi;
};

namespace gm {
template <bool F8> struct FragT { struct A4 { bf16x8 v[4][2]; }; struct B2 { bf16x8 v[2][2]; }; };
template <> struct FragT<true> { struct A4 { i32x8 v[4]; }; struct B2 { i32x8 v[2]; }; };
constexpr int BM = 256, BK = 64, HALF = 128, HTB = HALF * BK * 2, STAGE_BYTES = 8 * HTB;
__host__ __device__ __forceinline__ int lds_byte(int r, int c) { const int st = (r >> 4) * 2 + (c >> 5), rr = r & 15, cc = c & 31, ob = rr * 64 + cc * 2; return st * 1024 + (ob ^ (((ob >> 9) & 1) << 5)); }
__host__ __device__ __forceinline__ void stage_rc(int b, int& R, int& C) { const int st = b / 1024, sb = b % 1024, swz = sb ^ (((sb >> 9) & 1) << 5); R = (st >> 1) * 16 + swz / 64; C = (st & 1) * 32 + (swz % 64) / 2; }
__host__ __device__ __forceinline__ int perm32(int rho) { const int n = rho >> 4, i = rho & 15; return 8 * (i >> 2) + 4 * n + (i & 3); }

struct Unit { int pm, pn, aux, cnt; };

template <bool F8 = false, class Epi, class Sched>
__device__ __forceinline__ void gemm_phase(LAS unsigned char* lds, const int K, const Sched& S, const Epi& E, const int tid) {
    const int wid = __builtin_amdgcn_readfirstlane(tid >> 6), lane = tid & 63, wr = wid >> 2, wc = wid & 3, fr = lane & 15, fq = lane >> 4;
    const int nt = K / BK;
    int Rl0, Cl0; stage_rc(tid * 16, Rl0, Cl0);
    const int Rl[2] = {Rl0, Rl0 + 64}, Cl[2] = {Cl0, Cl0}; unsigned voffB[2];
#pragma unroll
    for (int i = 0; i < 2; ++i) voffB[i] = (unsigned)(Sched::brow(Rl[i]) * K + Cl[i]) * 2u;
    const size_t kstep = (size_t)(BK * 2);
    const size_t hstepB = S.hstepB();
    const unsigned ldsw = (unsigned)wid * 1024u;
    const int aoff = lds_byte(wr * 64 + fr, F8 ? fq * 16 : fq * 8), boff = lds_byte(wc * 32 + fr, F8 ? fq * 16 : fq * 8);
    const int aoff1 = aoff + (F8 ? 16 : 1024), boff1 = boff + (F8 ? 16 : 1024);
#define G_SA(b, h) (((b) * 2 + (h)) * HTB)
#define G_SB(b, h) ((4 + (b) * 2 + (h)) * HTB)
#define G_STAGE(bufoff, gbase, v0, v1) do { \
        __builtin_amdgcn_global_load_lds((const unsigned*)((const char*)(gbase) + (v0)), (LAS unsigned*)(lds + (bufoff) + ldsw), 16, 0, 0); \
        __builtin_amdgcn_global_load_lds((const unsigned*)((const char*)(gbase) + (v1)), (LAS unsigned*)(lds + (bufoff) + ldsw + 8192), 16, 0, 0); } while (0)
#define G_LDA(dst, b, h) do { _Pragma("unroll") for (int m = 0; m < 4; ++m) { \
        if constexpr (F8) { const i32x4 lo_ = *(const LAS i32x4*)(lds + G_SA(b, h) + aoff + m * 2048), hi_ = *(const LAS i32x4*)(lds + G_SA(b, h) + aoff1 + m * 2048); dst.v[m] = __builtin_shufflevector(lo_, hi_, 0, 1, 2, 3, 4, 5, 6, 7); } \
        else { _Pragma("unroll") for (int k = 0; k < 2; ++k) dst.v[m][k] = *(const LAS bf16x8*)(lds + G_SA(b, h) + (k ? aoff1 : aoff) + m * 2048); } } } while (0)
#define G_LDB(dst, b, h) do { _Pragma("unroll") for (int n = 0; n < 2; ++n) { \
        if constexpr (F8) { const i32x4 lo_ = *(const LAS i32x4*)(lds + G_SB(b, h) + boff + n * 2048), hi_ = *(const LAS i32x4*)(lds + G_SB(b, h) + boff1 + n * 2048); dst.v[n] = __builtin_shufflevector(lo_, hi_, 0, 1, 2, 3, 4, 5, 6, 7); } \
        else { _Pragma("unroll") for (int k = 0; k < 2; ++k) dst.v[n][k] = *(const LAS bf16x8*)(lds + G_SB(b, h) + (k ? boff1 : boff) + n * 2048); } } } while (0)
#define G_MMA(ai, bj, At, Bt) do { __builtin_amdgcn_s_setprio(1); _Pragma("unroll") for (int m = 0; m < 4; ++m) _Pragma("unroll") for (int n = 0; n < 2; ++n) { \
        if constexpr (F8) { asm volatile("v_mfma_f32_16x16x128_f8f6f4 %0, %1, %2, %0" : "+v"(acc[ai][bj][m][n]) : "v"(Bt.v[n]), "v"(At.v[m])); } \
        else { _Pragma("unroll") for (int k = 0; k < 2; ++k) acc[ai][bj][m][n] = __builtin_amdgcn_mfma_f32_16x16x32_bf16(Bt.v[n][k], At.v[m][k], acc[ai][bj][m][n], 0, 0, 0); } } \
        __builtin_amdgcn_s_setprio(0); } while (0)
#define G_WAIT_V(n) asm volatile("s_waitcnt vmcnt(" #n ")" ::: "memory")
#define G_WAIT_L(n) asm volatile("s_waitcnt lgkmcnt(" #n ")" ::: "memory")
#define G_BAR __builtin_amdgcn_s_barrier()
#define G_SCHED __builtin_amdgcn_sched_barrier(0)
    Unit cur, nxt; int ui = 0;
    if (!S.next(0, cur)) return;
    f32x4 acc[2][2][4][2];
#pragma unroll
    for (int a = 0; a < 2; ++a)
#pragma unroll
        for (int b = 0; b < 2; ++b)
#pragma unroll
            for (int m = 0; m < 4; ++m)
#pragma unroll
                for (int n = 0; n < 2; ++n) acc[a][b][m][n] = (f32x4){0.f, 0.f, 0.f, 0.f};
    typedef typename FragT<F8>::A4 FA; typedef typename FragT<F8>::B2 FB;
    FA At; FB B0, B1;
    const char* const Ab = S.a_base();
    const char* cB = S.b_base(cur);
    unsigned cA00 = S.a_off(cur, Rl[0]) + Cl[0] * 2, cA01 = S.a_off(cur, Rl[1]) + Cl[1] * 2, cA10 = S.a_off(cur, 128 + Rl[0]) + Cl[0] * 2, cA11 = S.a_off(cur, 128 + Rl[1]) + Cl[1] * 2;
    G_STAGE(G_SB(0, 0), cB, voffB[0], voffB[1]); G_STAGE(G_SB(0, 1), cB + hstepB, voffB[0], voffB[1]); G_STAGE(G_SA(0, 0), Ab, cA00, cA01); G_STAGE(G_SA(0, 1), Ab, cA10, cA11);
    if (wr == 1) G_BAR;
    G_WAIT_V(2); G_BAR;
    G_STAGE(G_SB(1, 0), cB + kstep, voffB[0], voffB[1]); G_STAGE(G_SA(1, 0), Ab + kstep, cA00, cA01); G_STAGE(G_SB(1, 1), cB + hstepB + kstep, voffB[0], voffB[1]);
    G_WAIT_V(6); G_BAR;
    for (;;) {
        const bool has_next = S.next(ui + 1, nxt);
        const char* nB = has_next ? S.b_base(nxt) : cB;
        unsigned nA00 = cA00, nA01 = cA01, nA10 = cA10, nA11 = cA11;
        if (has_next) { nA00 = S.a_off(nxt, Rl[0]) + Cl[0] * 2; nA01 = S.a_off(nxt, Rl[1]) + Cl[1] * 2; nA10 = S.a_off(nxt, 128 + Rl[0]) + Cl[0] * 2; nA11 = S.a_off(nxt, 128 + Rl[1]) + Cl[1] * 2; }
        for (int t = 0; t < nt; t += 2) {
            const bool last = (t == nt - 2);
            const char* a1 = Ab + (size_t)(t + 1) * kstep;
            const char* a2 = last ? Ab : Ab + (size_t)(t + 2) * kstep; const char* b2 = last ? nB : cB + (size_t)(t + 2) * kstep;
            const char* a3 = a2 + kstep; const char* b3 = b2 + kstep;
            const unsigned x00 = last ? nA00 : cA00, x01 = last ? nA01 : cA01, x10 = last ? nA10 : cA10, x11 = last ? nA11 : cA11;
            G_LDB(B0, 0, 0); G_LDB(B1, 0, 1); G_SCHED; G_LDA(At, 0, 0); G_STAGE(G_SA(1, 1), a1, cA10, cA11);
            G_WAIT_V(8); G_WAIT_L(0); G_BAR; G_MMA(0, 0, At, B0); G_MMA(0, 1, At, B1); G_BAR; G_SCHED;
            G_LDA(At, 0, 1); G_STAGE(G_SB(0, 0), b2, voffB[0], voffB[1]); G_STAGE(G_SB(0, 1), b2 + hstepB, voffB[0], voffB[1]); G_STAGE(G_SA(0, 0), a2, x00, x01);
            G_WAIT_V(8); G_WAIT_L(0); G_BAR; G_MMA(1, 0, At, B0); G_MMA(1, 1, At, B1); G_BAR; G_SCHED;
            G_LDB(B0, 1, 0); G_LDB(B1, 1, 1); G_SCHED; G_LDA(At, 1, 0); G_STAGE(G_SA(0, 1), a2, x10, x11);
            G_WAIT_V(8); G_WAIT_L(0); G_BAR; G_MMA(0, 0, At, B0); G_MMA(0, 1, At, B1); G_BAR; G_SCHED;
            G_LDA(At, 1, 1); G_STAGE(G_SB(1, 0), b3, voffB[0], voffB[1]); G_STAGE(G_SB(1, 1), b3 + hstepB, voffB[0], voffB[1]); G_STAGE(G_SA(1, 0), a3, x00, x01);
            G_WAIT_V(8); G_WAIT_L(0); G_BAR; G_MMA(1, 0, At, B0); G_MMA(1, 1, At, B1); G_BAR; G_SCHED;
        }
        if constexpr (F8) asm volatile("s_nop 15\n\ts_nop 15" ::: "memory");
        if (wr == 0) G_BAR;
        if constexpr (!Epi::AFTER_DRAIN) { E(acc, cur, wr, wc, fr, fq); }
        if (!has_next) break;
#pragma unroll
        for (int a = 0; a < 2; ++a)
#pragma unroll
            for (int b = 0; b < 2; ++b)
#pragma unroll
                for (int m = 0; m < 4; ++m)
#pragma unroll
                    for (int n = 0; n < 2; ++n) acc[a][b][m][n] = (f32x4){0.f, 0.f, 0.f, 0.f};
        cur = nxt; cB = nB; cA00 = nA00; cA01 = nA01; cA10 = nA10; cA11 = nA11; ++ui;
        if (wr == 1) G_BAR;
    }
    G_WAIT_V(0);
    G_BAR;
    if constexpr (Epi::AFTER_DRAIN) { E.fused(acc, cur, wr, wc, fr, fq, lds, wid, lane); }
#undef G_SA
#undef G_SB
#undef G_STAGE
#undef G_LDA
#undef G_LDB
#undef G_MMA
#undef G_WAIT_V
#undef G_WAIT_L
#undef G_BAR
#undef G_SCHED
}
}

constexpr int NXCD = 8, WGM = 8;
struct BrowStd  { static __host__ __device__ __forceinline__ int brow(int R) { return (R & ~31) + gm::perm32(R & 31); } };
struct BrowHead { static __host__ __device__ __forceinline__ int brow(int R) { return 64 * (R >> 5) + gm::perm32(R & 31); } };

template <class BR>
struct DenseSched : BR {
    const char* A; unsigned lda_bytes; const char* Bt; size_t tstepB_, hstepB_, bsplit = 0; int nM, nN, nwg, G, c;
    __device__ __forceinline__ void init(const void* A_, unsigned lda_b, const void* Bt_, size_t tstepB, size_t hstepB, int Mrows, int ntn, int G_, int c_) {
        A = (const char*)A_; lda_bytes = lda_b; Bt = (const char*)Bt_; tstepB_ = tstepB; hstepB_ = hstepB; nM = Mrows / 256; nN = ntn; nwg = nM * nN; G = G_; c = c_; }
    __device__ __forceinline__ bool next(int i, gm::Unit& u) const {
        const long L = (long)i * G + c; if (L >= nwg) return false;
        int wgid = (int)L; { const int q = nwg / NXCD, r = nwg % NXCD, xcd = wgid % NXCD, off = wgid / NXCD; wgid = (xcd < r ? xcd * (q + 1) : r * (q + 1) + (xcd - r) * q) + off; }
        const int nig = WGM * nN, gid = wgid / nig, fm = gid * WGM, gsz = (nM - fm) < WGM ? (nM - fm) : WGM;
        u.pm = fm + ((wgid % nig) % gsz); u.pn = (wgid % nig) / gsz; u.aux = 0; u.cnt = 0; return true;
    }
    __device__ __forceinline__ const char* a_base() const { return A; }
    __device__ __forceinline__ unsigned a_off(const gm::Unit& u, int row) const { return (unsigned)(u.pm * 256 + row) * lda_bytes; }
    __device__ __forceinline__ const char* b_base(const gm::Unit& u) const { return Bt + (size_t)(u.pm >> 6) * bsplit + (size_t)u.pn * tstepB_; }
    __device__ __forceinline__ size_t hstepB() const { return hstepB_; }
};

struct MoeSched : BrowStd {
    const char* A; const int* list; const char* Bt; size_t estride, tstepB_, hstepB_; int npn, G, c, ntot; bool gather;
    const LAS int* tstart; const LAS int* ecnt;
    __device__ __forceinline__ bool next(int i, gm::Unit& u) const {
        if (G == 256) {
            const int x = c >> 5; int L = i * 32 + (c & 31);
#pragma unroll 1
            for (int k = 0; k < 4; ++k) {
                const int e = x + 8 * k, t0 = __builtin_amdgcn_readfirstlane(tstart[e]), nt = __builtin_amdgcn_readfirstlane(tstart[e + 1]) - t0, units = nt * npn;
                if (L < units) { const int quad = nt * 4, pnh = L / quad, r2 = L - pnh * quad, rt = r2 >> 2; u.pn = pnh * 4 + (r2 & 3); u.pm = t0 + rt; u.aux = e; u.cnt = rt * 256; return true; }
                L -= units;
            }
            return false;
        }
        const long L = (long)i * G + c; if (L >= (long)ntot * npn) return false;
        const int rt = (int)(L / npn); u.pn = (int)(L % npn); u.pm = rt;
        int e = 0;
#pragma unroll 1
        for (int k = 1; k < NE; ++k) e = (__builtin_amdgcn_readfirstlane(tstart[k]) <= rt) ? k : e;
        u.aux = e; u.cnt = (rt - __builtin_amdgcn_readfirstlane(tstart[e])) * 256; return true;
    }
    __device__ __forceinline__ const char* a_base() const { return A; }
    __device__ __forceinline__ unsigned a_off(const gm::Unit& u, int row) const {
        if (gather) { const int last = __builtin_amdgcn_readfirstlane(ecnt[u.aux]) - 1; const int pos = min(u.cnt + row, last); return (unsigned)list[u.aux * M + pos] * 1024u; }
        return (unsigned)(u.pm * 256 + row) * 1024u;
    }
    __device__ __forceinline__ const char* b_base(const gm::Unit& u) const { return Bt + (size_t)u.aux * estride + (size_t)u.pn * tstepB_; }
    __device__ __forceinline__ size_t hstepB() const { return hstepB_; }
};

__device__ __forceinline__ size_t kimg_off(int t, int d) { return (size_t)(t >> 6) * 4096 + (d >> 3) * 512 + (t & 63) * 8 + (d & 7); }
__device__ __forceinline__ size_t vimg_off(int t, int d) { return (size_t)(t >> 6) * 4096 + (d >> 5) * 2048 + (t & 63) * 32 + (d & 31); }
__device__ __forceinline__ u32x4 pack8(const f32x4 a, const f32x4 b) { u32x4 w; w.x = pk2(a[0], a[1]); w.y = pk2(a[2], a[3]); w.z = pk2(b[0], b[1]); w.w = pk2(b[2], b[3]); return w; }
__device__ __forceinline__ void st8(bf16_t* p, const f32x4 a, const f32x4 b) { *(u32x4*)p = pack8(a, b); }

struct EpiFoxQKV {
    static constexpr bool AFTER_DRAIN = false;
    bf16_t* Q; const float* gain;
    __device__ __forceinline__ void operator()(const f32x4 (&acc)[2][2][4][2], const gm::Unit& u, int wr, int wc, int fr, int fq) const {
        const int hidx = 4 * u.pn + wc, kind = hidx >> 4, head = hidx & 15;
        bf16_t* base = Q + (size_t)kind * ((size_t)M * D) + head * 64 + 8 * fq;
        f32x4 g[2][2];
#pragma unroll
        for (int bj = 0; bj < 2; ++bj)
#pragma unroll
            for (int n = 0; n < 2; ++n) g[bj][n] = (kind < 2) ? *(const f32x4*)(gain + kind * 64 + 32 * bj + 8 * fq + 4 * n) : (f32x4){1.f, 1.f, 1.f, 1.f};
        const float sc = (kind == 0) ? C2 : 1.f;
#pragma unroll
        for (int ai = 0; ai < 2; ++ai)
#pragma unroll
            for (int m = 0; m < 4; ++m) {
                const int row = u.pm * 256 + ai * 128 + wr * 64 + m * 16 + fr;
                float rs = 1.f;
                if (kind < 2) {
                    float s = 0.f;
#pragma unroll
                    for (int bj = 0; bj < 2; ++bj)
#pragma unroll
                        for (int n = 0; n < 2; ++n) { const f32x4 v = acc[ai][bj][m][n]; s += (v[0] * v[0] + v[1] * v[1]) + (v[2] * v[2] + v[3] * v[3]); }
                    s += __shfl_xor(s, 16); s += __shfl_xor(s, 32);
                    rs = __builtin_amdgcn_rsqf(s * (1.f / 64.f) + EPS) * sc;
                }
                const int bb = row >> 13, tt = row & (T - 1);
                bf16_t* hb = Q + (size_t)kind * ((size_t)M * D) + ((size_t)(bb * NH + head) * T) * HD;
#pragma unroll
                for (int bj = 0; bj < 2; ++bj) { bf16_t* dst = kind == 0 ? base + (size_t)row * D + 32 * bj : hb + (kind == 1 ? kimg_off(tt, 32 * bj + 8 * fq) : vimg_off(tt, 32 * bj + 8 * fq));
                    *(u32x4*)dst = pack8(acc[ai][bj][m][0] * rs * g[bj][0], acc[ai][bj][m][1] * rs * g[bj][1]); }
            }
    }
};

struct EpiNsaKVQ {
    static constexpr bool AFTER_DRAIN = false;
    bf16_t* Q; bf16_t* kv6; const float* kgain; const float* qgain; const float* rope; const float* rstd;
    __device__ __forceinline__ void operator()(const f32x4 (&acc)[2][2][4][2], const gm::Unit& u, int wr, int wc, int fr, int fq) const {
        const int hidx = 4 * u.pn + wc;
        const bool isq = hidx >= 24; const int j = hidx >> 2, g = hidx & 3;
        const bool donorm = isq || j == 2 || j == 4;
        const float* gp = isq ? qgain : (kgain + (j == 2 ? 64 : 128));
        f32x4 gn[2][2];
#pragma unroll
        for (int bj = 0; bj < 2; ++bj)
#pragma unroll
            for (int n = 0; n < 2; ++n) gn[bj][n] = donorm ? *(const f32x4*)(gp + 32 * bj + 8 * fq + 4 * n) : (f32x4){1.f, 1.f, 1.f, 1.f};
        const float sc = isq ? C2 : 1.f;
#pragma unroll
        for (int ai = 0; ai < 2; ++ai)
#pragma unroll
            for (int m = 0; m < 4; ++m) {
                const int row = u.pm * 256 + ai * 128 + wr * 64 + m * 16 + fr; const int b = row >> 13, t = row & (T - 1);
                f32x4 v[2][2]; const float rr_ = rstd[row];
#pragma unroll
                for (int bj = 0; bj < 2; ++bj)
#pragma unroll
                    for (int n = 0; n < 2; ++n) v[bj][n] = acc[ai][bj][m][n] * rr_;
                if (donorm) {
                    float s = 0.f;
#pragma unroll
                    for (int bj = 0; bj < 2; ++bj)
#pragma unroll
                        for (int n = 0; n < 2; ++n) { const f32x4 w = v[bj][n]; s += (w[0] * w[0] + w[1] * w[1]) + (w[2] * w[2] + w[3] * w[3]); }
                    s += __shfl_xor(s, 16); s += __shfl_xor(s, 32);
                    const float rs = __builtin_amdgcn_rsqf(s * (1.f / 64.f) + EPS);
#pragma unroll
                    for (int bj = 0; bj < 2; ++bj)
#pragma unroll
                        for (int n = 0; n < 2; ++n) v[bj][n] = v[bj][n] * rs * gn[bj][n];
#pragma unroll
                    for (int n = 0; n < 2; ++n) {
                        const f32x4 cs0 = *(const f32x4*)(rope + ((size_t)t * 8 + 4 * n) * 2), cs1 = *(const f32x4*)(rope + ((size_t)t * 8 + 4 * n) * 2 + 4);
                        const float cc[4] = {cs0[0], cs0[2], cs1[0], cs1[2]}, ss[4] = {cs0[1], cs0[3], cs1[1], cs1[3]};
#pragma unroll
                        for (int jj = 0; jj < 4; ++jj) {
                            const float own = v[0][n][jj], oth = __shfl_xor(own, 16);
                            const float r0 = own * cc[jj] - oth * ss[jj], r1 = own * cc[jj] + oth * ss[jj];
                            v[0][n][jj] = fq == 0 ? r0 : (fq == 1 ? r1 : own);
                        }
                    }
#pragma unroll
                    for (int bj = 0; bj < 2; ++bj)
#pragma unroll
                        for (int n = 0; n < 2; ++n) v[bj][n] = v[bj][n] * sc;
                }
                bf16_t* hb = kv6 + (size_t)j * (KV6_STRIDE / 2) + ((size_t)(b * NG + g) * T) * HD;
#pragma unroll
                for (int bj = 0; bj < 2; ++bj) { const int d = 32 * bj + 8 * fq;
                    bf16_t* dst = isq ? (Q + (size_t)row * D + (hidx - 24) * 64 + d) : (j < 2 ? hb + (size_t)t * HD + d : ((j & 1) ? hb + vimg_off(t, d) : hb + kimg_off(t, d)));
                    *(u32x4*)dst = pack8(v[bj][0], v[bj][1]); }
            }
    }
};

template <class TB>
struct EpiResid {
    static constexpr bool AFTER_DRAIN = false;
    const TB* base; bf16_t* out;
    __device__ __forceinline__ void operator()(const f32x4 (&acc)[2][2][4][2], const gm::Unit& u, int wr, int wc, int fr, int fq) const {
        const int col0 = u.pn * 256 + wc * 32 + 8 * fq;
#pragma unroll
        for (int ai = 0; ai < 2; ++ai)
#pragma unroll
            for (int m = 0; m < 4; ++m) { const size_t off = (size_t)(u.pm * 256 + ai * 128 + wr * 64 + m * 16 + fr) * D + col0;
#pragma unroll
                for (int bj = 0; bj < 2; ++bj) { f32x4 b0, b1; ld8(base + off + bj * 128, b0, b1);
                    *(u32x4*)(out + off + bj * 128) = pack8(b0 + acc[ai][bj][m][0], b1 + acc[ai][bj][m][1]); } }
    }
};

struct EpiBf16 {
    static constexpr bool AFTER_DRAIN = false;
    bf16_t* O; int ldc;
    __device__ __forceinline__ void operator()(const f32x4 (&acc)[2][2][4][2], const gm::Unit& u, int wr, int wc, int fr, int fq) const {
        const int col0 = u.pn * 256 + wc * 32 + 8 * fq;
#pragma unroll
        for (int ai = 0; ai < 2; ++ai)
#pragma unroll
            for (int m = 0; m < 4; ++m) { bf16_t* rowp = O + (size_t)(u.pm * 256 + ai * 128 + wr * 64 + m * 16 + fr) * ldc + col0;
#pragma unroll
                for (int bj = 0; bj < 2; ++bj) *(u32x4*)(rowp + bj * 128) = pack8(acc[ai][bj][m][0], acc[ai][bj][m][1]); }
    }
};

template <class TO>
struct EpiPle {
    static constexpr bool AFTER_DRAIN = false;
    const bf16_t* xin; TO* out; const bf16_t* pp;
    __device__ __forceinline__ void operator()(const f32x4 (&acc)[2][2][4][2], const gm::Unit& u, int wr, int wc, int fr, int fq) const {
        const int col0 = u.pn * 256 + wc * 32 + 8 * fq;
#pragma unroll
        for (int ai = 0; ai < 2; ++ai)
#pragma unroll
            for (int m = 0; m < 4; ++m) { const size_t off = (size_t)(u.pm * 256 + ai * 128 + wr * 64 + m * 16 + fr) * D + col0;
#pragma unroll
                for (int bj = 0; bj < 2; ++bj) {
                    f32x4 b[2], pv[2], o[2]; ld8(xin + off + bj * 128, b[0], b[1]); ld8(pp + off + bj * 128, pv[0], pv[1]);
#pragma unroll
                    for (int n = 0; n < 2; ++n)
#pragma unroll
                        for (int jj = 0; jj < 4; ++jj) { const float sg = __builtin_amdgcn_rcpf(1.f + __builtin_amdgcn_exp2f(acc[ai][bj][m][n][jj] * (-W8_INV * LOG2E))); o[n][jj] = b[n][jj] + sg * pv[n][jj]; }
                    st8(out + off + bj * 128, o[0], o[1]); } }
    }
};

struct EpiSwiglu {
    static constexpr bool AFTER_DRAIN = false;
    unsigned char* Hb; const float* bgu;
    __device__ __forceinline__ void operator()(const f32x4 (&acc)[2][2][4][2], const gm::Unit& u, int wr, int wc, int fr, int fq) const {
        const int f0 = u.pn * 128 + wc * 32 + 8 * fq; const float* bb = bgu + (size_t)u.aux * 2048 + f0;
        f32x4 ba[2], bu[2];
#pragma unroll
        for (int n = 0; n < 2; ++n) { ba[n] = *(const f32x4*)(bb + 4 * n); bu[n] = *(const f32x4*)(bb + 1024 + 4 * n); }
#pragma unroll
        for (int ai = 0; ai < 2; ++ai)
#pragma unroll
            for (int m = 0; m < 4; ++m) { unsigned char* rowp = Hb + (size_t)(u.pm * 256 + ai * 128 + wr * 64 + m * 16 + fr) * FF + f0;
                f32x4 y[2];
#pragma unroll
                for (int n = 0; n < 2; ++n) { const f32x4 a4 = acc[ai][0][m][n] * W8_INV + ba[n], u4 = acc[ai][1][m][n] * W8_INV + bu[n];
#pragma unroll
                    for (int jj = 0; jj < 4; ++jj) { const float a = fminf(a4[jj], 7.f), uu = fminf(fmaxf(u4[jj], -7.f), 7.f); y[n][jj] = (uu + 1.f) * (a * __builtin_amdgcn_rcpf(1.f + __builtin_amdgcn_exp2f(a * (-1.702f * LOG2E)))); } }
                u32x2 o8; o8.x = pk4_fp8(y[0][0], y[0][1], y[0][2], y[0][3]); o8.y = pk4_fp8(y[1][0], y[1][1], y[1][2], y[1][3]); *(u32x2*)rowp = o8; }
    }
};

struct EpiDown {
    static constexpr bool AFTER_DRAIN = false;
    unsigned char* Y; const float* bdn; const float* gl;
    __device__ __forceinline__ void operator()(const f32x4 (&acc)[2][2][4][2], const gm::Unit& u, int wr, int wc, int fr, int fq) const {
        const int col0 = u.pn * 256 + wc * 32 + 8 * fq; const float* bb = bdn + (size_t)u.aux * D + col0;
        f32x4 bv[2][2];
#pragma unroll
        for (int bj = 0; bj < 2; ++bj)
#pragma unroll
            for (int n = 0; n < 2; ++n) bv[bj][n] = *(const f32x4*)(bb + bj * 128 + 4 * n);
#pragma unroll
        for (int ai = 0; ai < 2; ++ai)
#pragma unroll
            for (int m = 0; m < 4; ++m) { const int r = ai * 128 + wr * 64 + m * 16 + fr; int pos = u.cnt + r; pos = pos < M ? pos : M - 1;
                const float gt = gl[(size_t)u.aux * M + pos];
                unsigned char* rowp = Y + (size_t)(u.pm * 256 + r) * D + col0; const float gy = gt * Y8_SCALE;
#pragma unroll
                for (int bj = 0; bj < 2; ++bj) { const f32x4 y0 = (acc[ai][bj][m][0] * W8_INV + bv[bj][0]) * gy, y1 = (acc[ai][bj][m][1] * W8_INV + bv[bj][1]) * gy;
                    u32x2 o8; o8.x = pk4_fp8(y0[0], y0[1], y0[2], y0[3]); o8.y = pk4_fp8(y1[0], y1[1], y1[2], y1[3]); *(u32x2*)(rowp + bj * 128) = o8; } }
    }
};

struct Frame {
    LAS unsigned char* lds; int tid, lane, wave, G, vcu, gw, NGW, bx; unsigned char* ws;
};
#define WSP(T_, off) ((T_*)(F.ws + (off)))

__device__ __forceinline__ void transpose_item(const float* W, int ldw, const float* gain, bf16_t* WT, int ldwt, LAS float* scr, int k0, int n0, int lane, bool f8) {
    f32x4 v[16]; const int rr = lane >> 4, cc = 4 * (lane & 15);
#pragma unroll
    for (int i = 0; i < 16; ++i) v[i] = __builtin_nontemporal_load((const f32x4*)(W + (size_t)(k0 + 4 * i + rr) * ldw + n0 + cc));
#pragma unroll
    for (int i = 0; i < 16; ++i) { const int kk = 4 * i + rr; const float gk = gain ? gain[k0 + kk] : 1.f; LAS float* d = scr + kk * 65 + cc;
        d[0] = v[i][0] * gk; d[1] = v[i][1] * gk; d[2] = v[i][2] * gk; d[3] = v[i][3] * gk; }
    LDS_WAIT(); asm volatile("" ::: "memory");
    const int c = lane & 7;
    if (f8) {
#pragma unroll
        for (int p = 0; p < 8; ++p) { const int n = 8 * p + (lane >> 3); const LAS float* s = scr + (8 * c) * 65 + n;
            u32x2 o; o.x = pk4_fp8(s[0 * 65] * W8_SCALE, s[1 * 65] * W8_SCALE, s[2 * 65] * W8_SCALE, s[3 * 65] * W8_SCALE); o.y = pk4_fp8(s[4 * 65] * W8_SCALE, s[5 * 65] * W8_SCALE, s[6 * 65] * W8_SCALE, s[7 * 65] * W8_SCALE);
            *(u32x2*)((unsigned char*)WT + (size_t)(n0 + n) * ldwt + k0 + 8 * c) = o; }
        LDS_WAIT(); asm volatile("" ::: "memory");
        return;
    }
#pragma unroll
    for (int p = 0; p < 8; ++p) { const int n = 8 * p + (lane >> 3); const LAS float* s = scr + (8 * c) * 65 + n;
        u32x4 o; o.x = pk2(s[0 * 65], s[1 * 65]); o.y = pk2(s[2 * 65], s[3 * 65]); o.z = pk2(s[4 * 65], s[5 * 65]); o.w = pk2(s[6 * 65], s[7 * 65]);
        *(u32x4*)(WT + (size_t)(n0 + n) * ldwt + k0 + 8 * c) = o; }
    LDS_WAIT(); asm volatile("" ::: "memory");
}
struct TJob { const float* W; int ldw, K, N; const float* gain; bf16_t* WT; size_t wstride, tstride, gstride; int nmat; bool f8; };
__device__ __forceinline__ bool run_tjob(const TJob& J, int& r, LAS float* scr, int lane) {
    const int nkb = J.K / 64, nnb = J.N / 64, per = nkb * nnb, total = per * J.nmat;
    if (r >= total) { r -= total; return false; }
    const int m = r / per, q = r % per, kb = q / nnb, nb = q % nnb;
    const bool f8 = J.f8;
    transpose_item(J.W + (size_t)m * J.wstride, J.ldw, J.gain ? J.gain + (size_t)(m / 32) * J.gstride : nullptr, f8 ? (bf16_t*)((unsigned char*)J.WT + (size_t)m * J.tstride) : J.WT + (size_t)m * J.tstride, J.K, scr, kb * 64, nb * 64, lane, f8);
    return true;
}

__device__ __forceinline__ void phase_prologue(Frame& F, const Params& P) {
    LAS float* scr = (LAS float*)(F.lds + F.wave * 16640);
    constexpr int NITEMS = 16 * 48 + 256 + 16 * 24 + 256 + 256 + 256 + 256 + 2 * 4 * 16 + 2 * 32 * 4 + 2 * 4 * 1 + 32 * 16 * 32 + 32 * 16 * 16;
#define TJ(...) { const TJob J_ = {__VA_ARGS__}; if (run_tjob(J_, r, scr, F.lane)) continue; }
    for (int it = F.gw; it < NITEMS; it += F.NGW) {
        int r = it;
        TJ(P.fox_w_in, FOXN, 1024, 3072, P.attn_norm, WSP(bf16_t, WS_WFOXIN), 0, 0, 0, 1, false)
        TJ(P.fox_w_out, 1024, 1024, 1024, nullptr, WSP(bf16_t, WS_WFOXOUT), 0, 0, 0, 1, false)
        TJ(P.kv_w, KVN, 1024, KVN, P.kv_norm, WSP(bf16_t, WS_WNSA), 0, 0, 0, 1, false)
        TJ(P.nsa_w_in, NSAN, 1024, 1024, P.attn_norm + D, WSP(bf16_t, WS_WNSA) + (size_t)KVN * 1024, 0, 0, 0, 1, false)
        TJ(P.nsa_w_out, 1024, 1024, 1024, nullptr, WSP(bf16_t, WS_WNSAOUT), 0, 0, 0, 1, false)
        TJ(P.ple_gate_w, 1024, 1024, 1024, P.ple_norm, WSP(bf16_t, WS_WPLEG), 0, 0, 0, 1, true)
        TJ(P.ple_gate_w + (size_t)D * D, 1024, 1024, 1024, P.ple_norm + D, (bf16_t*)(WSP(unsigned char, WS_WPLEG) + (size_t)D * D), 0, 0, 0, 1, true)
        TJ(P.ple_proj_w, 1024, 256, 1024, nullptr, WSP(bf16_t, WS_WPLEP), (size_t)PLE * D, (size_t)PLE * D, 0, 2, false)
        TJ(P.cmp_w1, 256, 2048, 256, nullptr, WSP(bf16_t, WS_WC1), (size_t)2048 * 256, (size_t)2048 * 256, 0, 2, false)
        TJ(P.cmp_w2, 64, 256, 64, nullptr, WSP(bf16_t, WS_WC2), (size_t)256 * 64, (size_t)256 * 64, 0, 2, false)
        TJ(P.w_gu, 2048, 1024, 2048, P.ffn_norm, WSP(bf16_t, WS_WGU), (size_t)1024 * 2048, (size_t)1024 * 2048, (size_t)D, 32, true)
        TJ(P.w_down, 1024, 1024, 1024, nullptr, WSP(bf16_t, WS_WDN), (size_t)1024 * 1024, (size_t)1024 * 1024, 0, 32, true)
    }
#undef TJ
    const int gt = F.vcu * NTHREADS + F.tid, NGT = F.G * NTHREADS;
    float* rope = WSP(float, WS_ROPE);
    for (int i = gt; i < T * 8; i += NGT) { const int t = i >> 3, c = i & 7; const double inv = pow(500000.0, -(double)c / 8.0), ang = (double)t * inv; rope[2 * i] = (float)cos(ang); rope[2 * i + 1] = (float)sin(ang); }
    float* wft = WSP(float, WS_WFT);
    for (int i = gt; i < 32 * 1024; i += NGT) { const int h = i >> 10, k = i & 1023; wft[i] = h < 16 ? P.attn_norm[k] * P.fox_w_in[(size_t)k * FOXN + 3072 + h] : 0.f; }
    float* wrt = WSP(float, WS_WRT);
    for (int i = gt; i < 2 * 32 * 1024; i += NGT) { const int l = i >> 15, e = (i >> 10) & 31, k = i & 1023; wrt[i] = P.ffn_norm[l * D + k] * P.router_w[((size_t)l * D + k) * NE + e]; }
    float* wgt = WSP(float, WS_WGT);
    for (int i = gt; i < 64 * 1024; i += NGT) { const int c = i >> 10, k = i & 1023; wgt[i] = c < 48 ? P.attn_norm[D + k] * P.nsa_w_in[(size_t)k * NSAN + 1024 + c] : 0.f; }
    { const f32x4* src = (const f32x4*)P.p; u32x2* dst = WSP(u32x2, WS_PBF);
      for (int i = gt; i < 2 * M * PLE / 4; i += NGT) { const f32x4 v = src[i]; u32x2 o; o.x = pk2(v[0], v[1]); o.y = pk2(v[2], v[3]); dst[i] = o; } }
    { float* part = WSP(float, WS_H);
      for (int task = F.gw; task < 2 * 4 * 32; task += F.NGW) { const int j = task >> 7, cg = (task >> 5) & 3, mc = task & 31; const int c = cg * 64 + F.lane;
        const float* w = P.cmp_w1 + ((size_t)j * 2048 + mc * 64) * 256 + c; const float* pp = P.cmp_pos + j * 2048 + mc * 64; float s = 0.f;
#pragma unroll 8
        for (int m = 0; m < 64; ++m) s += pp[m] * w[(size_t)m * 256];
        part[(j * 32 + mc) * 256 + c] = s; } }
}

constexpr int L1_ITEMS = 32 * 16 * 32 + 32 * 16 * 16, L1_SPLIT = 8192;
__device__ __forceinline__ void convert_moe_l1(Frame& F, const Params& P, int worker, int nworkers, int it_lo, int it_hi) {
    LAS float* scr = (LAS float*)(F.lds + F.wave * 16640);
    const int w = worker * NWAVES + F.wave, NW = nworkers * NWAVES;
#define TJ(...) { const TJob J_ = {__VA_ARGS__}; if (run_tjob(J_, r, scr, F.lane)) continue; }
    for (int it = it_lo + w; it < it_hi; it += NW) {
        int r = it;
        TJ(P.w_gu + (size_t)32 * 1024 * 2048, 2048, 1024, 2048, P.ffn_norm + D, (bf16_t*)(WSP(unsigned char, WS_WGU) + (size_t)32 * 1024 * 2048), (size_t)1024 * 2048, (size_t)1024 * 2048, 0, 32, true)
        TJ(P.w_down + (size_t)32 * 1024 * 1024, 1024, 1024, 1024, nullptr, (bf16_t*)(WSP(unsigned char, WS_WDN) + (size_t)32 * 1024 * 1024), (size_t)1024 * 1024, (size_t)1024 * 1024, 0, 32, true)
    }
#undef TJ
}

template <class TX>
__device__ __forceinline__ void row_load(const TX* xrow, int lane, f32x4 (&v)[4]) {
#pragma unroll
    for (int j = 0; j < 4; ++j) v[j] = ld4(xrow + 4 * lane + 256 * j);
}
__device__ __forceinline__ float row_rstd(const f32x4 (&v)[4]) {
    float s = 0.f;
#pragma unroll
    for (int j = 0; j < 4; ++j) s += (v[j][0] * v[j][0] + v[j][1] * v[j][1]) + (v[j][2] * v[j][2] + v[j][3] * v[j][3]);
    return __builtin_amdgcn_rsqf(wave_sum(s) * (1.f / D) + EPS);
}
__device__ __forceinline__ void row_store_bf16(bf16_t* orow, int lane, const f32x4 (&v)[4]) {
    u32x2* o8 = (u32x2*)orow + lane;
#pragma unroll
    for (int j = 0; j < 4; ++j) { u32x2 o; o.x = pk2(v[j][0], v[j][1]); o.y = pk2(v[j][2], v[j][3]); o8[64 * j] = o; }
}
__device__ __forceinline__ float row_dot(const f32x4 (&v)[4], const float* w, int lane) {
    const f32x4* wr = (const f32x4*)w + lane; float s = 0.f;
#pragma unroll
    for (int j = 0; j < 4; ++j) { const f32x4 a = wr[64 * j]; s += (v[j][0] * a[0] + v[j][1] * a[1]) + (v[j][2] * a[2] + v[j][3] * a[3]); }
    return s;
}
__device__ __forceinline__ float reduce16(float (&p)[16], int lane) {
#pragma unroll
    for (int i = 0; i < 8; ++i) { const bool up = lane & 32; const float send = up ? p[i] : p[i + 8], keep = up ? p[i + 8] : p[i]; p[i] = keep + __shfl_xor(send, 32); }
#pragma unroll
    for (int i = 0; i < 4; ++i) { const bool up = lane & 16; const float send = up ? p[i] : p[i + 4], keep = up ? p[i + 4] : p[i]; p[i] = keep + __shfl_xor(send, 16); }
#pragma unroll
    for (int i = 0; i < 2; ++i) { const bool up = lane & 8; const float send = up ? p[i] : p[i + 2], keep = up ? p[i + 2] : p[i]; p[i] = keep + __shfl_xor(send, 8); }
    { const bool up = lane & 4; const float send = up ? p[0] : p[1], keep = up ? p[1] : p[0]; p[0] = keep + __shfl_xor(send, 4); }
    p[0] += __shfl_xor(p[0], 2); p[0] += __shfl_xor(p[0], 1);
    return p[0];
}

template <int NT, bool Q8 = false, class TX, class Post>
__device__ __forceinline__ void rowblock_phase(Frame& F, const TX* xsrc, const float* WT, bf16_t* xn, Post post) {
    constexpr int RS = NT * 32 + 1;
    const int lane = F.lane, wid = F.wave, task = wid >> 2, q = wid & 3, i = lane & 31, kh = lane >> 5;
    LAS float* PART = (LAS float*)F.lds;
    LAS float* SSQ = PART + 2 * 4 * 32 * RS;
    LAS float* RSTD = SSQ + 2 * 4 * 2 * 32;
    for (int blk = F.vcu; blk < M / 64; blk += F.G) {
        const int r0 = blk * 64 + task * 32;
        f32x16 acc[NT];
#pragma unroll
        for (int t = 0; t < NT; ++t) acc[t] = splat16z();
        float ssq = 0.f;
        const TX* xr = xsrc + (size_t)(r0 + i) * D + 256 * q + 8 * kh;
        const float* wr = WT + (size_t)i * D + 256 * q + 8 * kh;
#pragma unroll 2
        for (int s = 0; s < 16; ++s) {
            f32x4 a0, a1; ld8(xr + 16 * s, a0, a1);
            ssq += ((a0[0] * a0[0] + a0[1] * a0[1]) + (a0[2] * a0[2] + a0[3] * a0[3])) + ((a1[0] * a1[0] + a1[1] * a1[1]) + (a1[2] * a1[2] + a1[3] * a1[3]));
#pragma unroll
            for (int t = 0; t < NT; ++t) { const f32x4 b0 = *(const f32x4*)(wr + (size_t)t * 32 * D + 16 * s), b1 = *(const f32x4*)(wr + (size_t)t * 32 * D + 16 * s + 4);
#pragma unroll
                for (int q4 = 0; q4 < 4; ++q4) acc[t] = __builtin_amdgcn_mfma_f32_32x32x2f32(a0[q4], b0[q4], acc[t], 0, 0, 0);
#pragma unroll
                for (int q4 = 0; q4 < 4; ++q4) acc[t] = __builtin_amdgcn_mfma_f32_32x32x2f32(a1[q4], b1[q4], acc[t], 0, 0, 0); }
        }
        LAS float* pp = PART + ((task * 4 + q) * 32) * RS;
#pragma unroll
        for (int t = 0; t < NT; ++t)
#pragma unroll
            for (int r = 0; r < 16; ++r) pp[((r & 3) + 8 * (r >> 2) + 4 * kh) * RS + 32 * t + i] = acc[t][r];
        SSQ[((task * 4 + q) * 2 + kh) * 32 + i] = ssq;
        __syncthreads();
        if (q == 0 && lane < 32) {
            float sq = 0.f;
#pragma unroll
            for (int k = 0; k < 8; ++k) sq += SSQ[(task * 8 + k) * 32 + i];
            const float rstd = __builtin_amdgcn_rsqf(sq * (1.f / D) + EPS);
            RSTD[task * 32 + i] = rstd;
            const LAS float* p0 = PART + ((task * 4) * 32 + i) * RS;
            post(r0 + i, rstd, [&](int c) { return (p0[c] + p0[32 * RS + c]) + (p0[64 * RS + c] + p0[96 * RS + c]); });
        }
        __syncthreads();
        if (xn != nullptr)
#pragma unroll 2
        for (int rr = 0; rr < 8; ++rr) {
            const int row = r0 + 8 * q + rr; const float rstd = RSTD[task * 32 + 8 * q + rr];
            f32x4 v[4]; row_load(xsrc + (size_t)row * D, lane, v);
#pragma unroll
            for (int j = 0; j < 4; ++j) v[j] = v[j] * rstd;
            if constexpr (Q8) { unsigned* o4 = (unsigned*)((unsigned char*)xn + (size_t)row * D) + lane;
#pragma unroll
                for (int j = 0; j < 4; ++j) o4[64 * j] = pk4_fp8(v[j][0], v[j][1], v[j][2], v[j][3]); }
            else row_store_bf16(xn + (size_t)row * D, lane, v);
        }
        __syncthreads();
    }
}

__device__ __forceinline__ void phase_fox_pre(Frame& F, const Params& P) {
    if (F.vcu == 0) { const float* part = WSP(float, WS_H); float* cb1 = WSP(float, WS_CB1); const int i = F.tid; const int j = i >> 8, c = i & 255; float s = 0.f;
        for (int mc = 0; mc < 32; ++mc) s += part[(j * 32 + mc) * 256 + c];
        cb1[i] = s; }
    float* logf = WSP(float, WS_LOGF); const float* bf = P.fox_b_f;
    rowblock_phase<1>(F, P.x, WSP(float, WS_WFT), WSP(bf16_t, WS_XN), [&](int row, float rstd, auto get) {
        const size_t base = (size_t)(row >> 13) * NH * T + (row & (T - 1));
#pragma unroll
        for (int h = 0; h < 16; ++h) { const float z = rstd * get(h) + bf[h]; logf[base + (size_t)h * T] = fminf(z, 0.f) - log1pf(__expf(-fabsf(z))); }
    });
}

__device__ __forceinline__ void fox_scan(Frame& F, int bh) {
    const float* lf = WSP(float, WS_LOGF) + (size_t)bh * T; float* bias = WSP(float, WS_BIAS) + (size_t)bh * T; u32x4* kaug = WSP(u32x4, WS_KAUG) + (size_t)bh * T;
    LAS float* sc = (LAS float*)(F.lds);
    float v[16]; float run = 0.f;
    const f32x4* src = (const f32x4*)(lf + F.tid * 16);
#pragma unroll
    for (int i = 0; i < 4; ++i) { const f32x4 a = src[i]; v[4 * i] = a[0]; v[4 * i + 1] = a[1]; v[4 * i + 2] = a[2]; v[4 * i + 3] = a[3]; }
#pragma unroll
    for (int i = 0; i < 16; ++i) { run += v[i]; v[i] = run; }
    const float incl = wave_scan_f(run);
    if (F.lane == 63) sc[F.wave] = incl;
    __syncthreads();
    float woff = 0.f;
    for (int w = 0; w < F.wave; ++w) woff += sc[w];
    const float base = woff + incl - run;
#pragma unroll
    for (int i = 0; i < 16; ++i) {
        const float bv = -(base + v[i]) * LOG2E;
        const unsigned b0 = f2bf(bv); const float r1 = bv - __builtin_bit_cast(float, b0 << 16);
        const unsigned b1 = f2bf(r1); const float r2 = r1 - __builtin_bit_cast(float, b1 << 16);
        const unsigned b2 = f2bf(r2);
        bias[F.tid * 16 + i] = bv;
        u32x4 o; o.x = b0 | (b1 << 16); o.y = b2 | 0x3F800000u; o.z = 0x3F803F80u; o.w = 0u; kaug[F.tid * 16 + i] = o;
    }
    __syncthreads();
}

__device__ __forceinline__ void phase_moe_route(Frame& F, const Params& P, int layer, const bf16_t* xsrc, int cbank = -1) {
    unsigned* cnt = WSP(unsigned, WS_CTL) + CW_CNT + (cbank < 0 ? layer : cbank) * NE * CNT_STRIDE; int* list = WSP(int, WS_LIST); float* gl = WSP(float, WS_GL); int* tokinfo = WSP(int, WS_TOKINFO);
    const float* rb = P.router_b + layer * NE;
    rowblock_phase<1, true>(F, xsrc, WSP(float, WS_WRT) + (size_t)layer * NE * D, WSP(bf16_t, WS_XN8), [&](int row, float rstd, auto get) {
        float v[NE];
#pragma unroll
        for (int e = 0; e < NE; ++e) v[e] = rstd * get(e) + rb[e];
        float tv[4]; int te[4];
#pragma unroll
        for (int k = 0; k < 4; ++k) {
            float best = -INFINITY; int bi = 0;
#pragma unroll
            for (int e = 0; e < NE; ++e) { const bool tk = v[e] > best; best = tk ? v[e] : best; bi = tk ? e : bi; }
            tv[k] = best; te[k] = bi;
#pragma unroll
            for (int e = 0; e < NE; ++e) v[e] = (e == bi) ? -INFINITY : v[e];
        }
        const float e1 = __expf(tv[1] - tv[0]), e2 = __expf(tv[2] - tv[0]), e3 = __expf(tv[3] - tv[0]);
        const float inv = 1.f / (1.f + e1 + e2 + e3);
        const float gk[4] = {inv, e1 * inv, e2 * inv, e3 * inv};
        LAS unsigned* hist = (LAS unsigned*)(F.lds + LDS_MISC + 640) + (F.wave >> 2) * 64;
        const int li = F.lane;
        hist[li] = 0u; LDS_WAIT(); asm volatile("" ::: "memory");
        unsigned rk[4];
#pragma unroll
        for (int k = 0; k < 4; ++k) rk[k] = __hip_atomic_fetch_add(hist + te[k], 1u, __ATOMIC_RELAXED, __HIP_MEMORY_SCOPE_WORKGROUP);
        LDS_WAIT(); asm volatile("" ::: "memory");
        { const unsigned c = hist[li]; unsigned base = 0u; if (c) base = atomicAdd(cnt + li * CNT_STRIDE, c); hist[32 + li] = base; }
        LDS_WAIT(); asm volatile("" ::: "memory");
#pragma unroll
        for (int k = 0; k < 4; ++k) {
            const int e = te[k]; const unsigned pos = hist[32 + e] + rk[k];
            list[(size_t)e * M + pos] = row; gl[(size_t)e * M + pos] = gk[k]; tokinfo[row * 4 + k] = (e << 16) | (int)pos;
        }
    });
}

__device__ __forceinline__ int moe_tables(Frame& F, int layer, LAS int* tstart, LAS int* ecnt) {
    const unsigned* cnt = WSP(unsigned, WS_CTL) + CW_CNT + layer * NE * CNT_STRIDE;
    if (F.tid < NE) ecnt[F.tid] = (int)__hip_atomic_load(cnt + F.tid * CNT_STRIDE, __ATOMIC_RELAXED, __HIP_MEMORY_SCOPE_AGENT);
    __syncthreads();
    if (F.tid == 0) { int s = 0; for (int e = 0; e < NE; ++e) { tstart[e] = s; s += (ecnt[e] + 255) >> 8; } tstart[NE] = s; }
    __syncthreads();
    return __builtin_amdgcn_readfirstlane(tstart[NE]);
}

__device__ __forceinline__ void phase_moe_combine(Frame& F, int layer, const bf16_t* xsrc) {
    LAS int* tstart = (LAS int*)(F.lds + LDS_MISC); LAS int* ecnt = tstart + 64;
    moe_tables(F, layer, tstart, ecnt);
    const int* tokinfo = WSP(int, WS_TOKINFO); const unsigned char* Y = WSP(unsigned char, WS_Y); bf16_t* xb = WSP(bf16_t, WS_XB);
    for (int row = F.gw; row < M; row += F.NGW) {
        f32x4 v[4]; row_load(xsrc + (size_t)row * D, F.lane, v);
#pragma unroll
        for (int k = 0; k < 4; ++k) {
            const int ti = tokinfo[row * 4 + k]; const int e = ti >> 16, pos = ti & 0xffff; const size_t slot = (size_t)tstart[e] * 256 + pos;
            const unsigned* yr = (const unsigned*)(Y + slot * D) + F.lane;
#pragma unroll
            for (int j = 0; j < 4; ++j) { const int w = (int)yr[64 * j]; const f32x2 lo = __builtin_amdgcn_cvt_pk_f32_fp8(w, false), hi2 = __builtin_amdgcn_cvt_pk_f32_fp8(w, true);
                v[j][0] += lo[0] * Y8_INV; v[j][1] += lo[1] * Y8_INV; v[j][2] += hi2[0] * Y8_INV; v[j][3] += hi2[1] * Y8_INV; }
        }
#pragma unroll
        for (int j = 0; j < 4; ++j) st4(xb + (size_t)row * D + 4 * F.lane + 256 * j, v[j]);
        const float rs = row_rstd(v);
#pragma unroll
        for (int j = 0; j < 4; ++j) v[j] = v[j] * rs;
        { unsigned* o4 = (unsigned*)(WSP(unsigned char, WS_XN8) + (size_t)row * D) + F.lane;
#pragma unroll
          for (int j = 0; j < 4; ++j) o4[64 * j] = pk4_fp8(v[j][0], v[j][1], v[j][2], v[j][3]); }
    }
}

__device__ __forceinline__ void phase_nsa_pre(Frame& F) {
    float* gates = WSP(float, WS_GATES);
    float* rstd_out = WSP(float, WS_RSTD);
    rowblock_phase<2>(F, WSP(bf16_t, WS_XB), WSP(float, WS_WGT), (bf16_t*)nullptr, [&](int row, float rstd, auto get) {
        rstd_out[row] = rstd;
#pragma unroll
        for (int c4 = 0; c4 < 12; ++c4) { f32x4 o;
#pragma unroll
            for (int jj = 0; jj < 4; ++jj) o[jj] = 1.f / (1.f + __expf(-rstd * get(4 * c4 + jj)));
            *(f32x4*)(gates + (size_t)row * 48 + 4 * c4) = o; }
    });
}

constexpr int AT_K0 = 0  , AT_V0 = 16384  , AT_OST = 0  , AT_WSF = 40960, AT_IMP = 43008, AT_SELM = 75776, AT_OT = 76800, AT_END = AT_OT + 65536;
static_assert(AT_END <= LDS_MISC, "attention LDS map vs control words");
static_assert(AT_END <= LDS_BYTES, "attention LDS map");
__device__ __forceinline__ int crow(int r, int hi) { return (r & 3) + 8 * (r >> 2) + 4 * hi; }
__device__ __forceinline__ unsigned cvtpk(float lo, float hi) { f32x2 v = {lo, hi}; bf16x2_t b = __builtin_convertvector(v, bf16x2_t); return __builtin_bit_cast(unsigned, b); }
typedef short v4i16_t __attribute__((ext_vector_type(4)));
__device__ __forceinline__ s16x4 vtr(const LAS char* p) { return __builtin_bit_cast(s16x4, __builtin_amdgcn_ds_read_tr16_b64_v4i16((LAS v4i16_t*)p)); }

__device__ __forceinline__ void glds16(const void* gsrc, unsigned lds_dst) { unsigned keep;
    asm volatile("s_mov_b32 %0, m0\n\ts_mov_b32 m0, %2\n\ts_nop 0\n\tglobal_load_lds_dwordx4 %1, off\n\ts_mov_b32 m0, %0" : "=&s"(keep) : "v"(gsrc), "s"(lds_dst) : "memory"); }
#define WAIT_BAR0() asm volatile("s_waitcnt vmcnt(0) lgkmcnt(0)\n\ts_barrier" ::: "memory")
__device__ __forceinline__ void tile_dma(const bf16_t* Kt, const bf16_t* Vt, LAS unsigned char* lds, int buf, int tid, int wave) {
    const unsigned base = (unsigned)(uintptr_t)lds + (unsigned)wave * 1024u + (unsigned)buf * 8192u;
    glds16(Kt + tid * 8, (unsigned)__builtin_amdgcn_readfirstlane((int)(base + AT_K0)));
    glds16(Vt + tid * 8, (unsigned)__builtin_amdgcn_readfirstlane((int)(base + AT_V0)));
}
struct TileRegs { u32x4 k, v; };
__device__ __forceinline__ void tile_load(TileRegs& r, const bf16_t* Kt, const bf16_t* Vt, int stride, int tid) {
    (void)stride;
    r.k = *(const u32x4*)(Kt + tid * 8);
    r.v = *(const u32x4*)(Vt + tid * 8);
}
__device__ __forceinline__ void tile_store(const TileRegs& r, LAS unsigned char* lds, int buf, int tid) {
    *(LAS u32x4*)(lds + AT_K0 + buf * 8192 + tid * 16) = r.k;
    *(LAS u32x4*)(lds + AT_V0 + buf * 8192 + tid * 16) = r.v;
}
__device__ __forceinline__ void qk_tile(f32x16& p0, f32x16& p1, const LAS unsigned char* Kbuf, const bf16x8 (&qr)[4], int r32, int hi) {
    const f32x16 cinit = {0.f, 0.f, 0.f, 0.f, 0.f, 0.f, 0.f, 0.f, 0.f, 0.f, 0.f, 0.f, 0.f, 0.f, 0.f, 0.f};
    const LAS unsigned char* kb = Kbuf + hi * 1024 + r32 * 16;
    bf16x8 kf[8];
#pragma unroll
    for (int d0 = 0; d0 < 4; ++d0) { kf[d0] = *(const LAS bf16x8*)(kb + d0 * 2048); kf[4 + d0] = *(const LAS bf16x8*)(kb + d0 * 2048 + 512); }
    __builtin_amdgcn_sched_barrier(0);
#pragma unroll
    for (int d0 = 0; d0 < 4; ++d0) p0 = __builtin_amdgcn_mfma_f32_32x32x16_bf16(kf[d0], qr[d0], d0 ? p0 : cinit, 0, 0, 0);
#pragma unroll
    for (int d0 = 0; d0 < 4; ++d0) p1 = __builtin_amdgcn_mfma_f32_32x32x16_bf16(kf[4 + d0], qr[d0], d0 ? p1 : cinit, 0, 0, 0);
}
struct VFrag { s16x4 lo[2][4], hh[2][4]; };
__device__ __forceinline__ void v_load(VFrag& vf, const LAS unsigned char* Vbuf, int lane) {
    const int hi = lane >> 5;
    const LAS char* vp = (const LAS char*)Vbuf + ((lane >> 4) & 1) * 32 + (lane & 3) * 8 + (4 * hi + ((lane & 15) >> 2)) * 64;
#pragma unroll
    for (int d0 = 0; d0 < 2; ++d0)
#pragma unroll
        for (int ks = 0; ks < 4; ++ks) { vf.lo[d0][ks] = vtr(vp + d0 * 4096 + ks * 1024); vf.hh[d0][ks] = vtr(vp + d0 * 4096 + ks * 1024 + 512); }
    __builtin_amdgcn_sched_barrier(0);
}
__device__ __forceinline__ void pv_tile(f32x16 (&o)[2], const VFrag& vf, const f32x16& p0, const f32x16& p1) {
    u32x4 pw[4];
#pragma unroll
    for (int i = 0; i < 4; ++i) { pw[0][i] = cvtpk(p0[2 * i], p0[2 * i + 1]); pw[1][i] = cvtpk(p0[8 + 2 * i], p0[9 + 2 * i]); pw[2][i] = cvtpk(p1[2 * i], p1[2 * i + 1]); pw[3][i] = cvtpk(p1[8 + 2 * i], p1[9 + 2 * i]); }
#pragma unroll
    for (int d0 = 0; d0 < 2; ++d0)
#pragma unroll
        for (int ks = 0; ks < 4; ++ks) {
            const bf16x8 v8 = (bf16x8){vf.lo[d0][ks][0], vf.lo[d0][ks][1], vf.lo[d0][ks][2], vf.lo[d0][ks][3], vf.hh[d0][ks][0], vf.hh[d0][ks][1], vf.hh[d0][ks][2], vf.hh[d0][ks][3]};
            o[d0] = __builtin_amdgcn_mfma_f32_32x32x16_bf16(__builtin_bit_cast(bf16x8, pw[ks]), v8, o[d0], 0, 0, 0);
        }
}
__device__ __forceinline__ float half_swap_add(float v) { return xor32_sum(v); }
__device__ __forceinline__ f32x16 splat16(float v) { f32x16 r;
#pragma unroll
    for (int i = 0; i < 16; ++i) r[i] = v; return r; }
__device__ __forceinline__ float psum(const f32x16& p0, const f32x16& p1) { float s = 0.f;
#pragma unroll
    for (int r = 0; r < 16; ++r) s += p0[r] + p1[r]; return s; }

template <class RowPtr>
__device__ __forceinline__ void store_o(const f32x16 (&o)[2], LAS unsigned char* lds, int wid, int lane, RowPtr rowptr) {
    const int r32 = lane & 31, hi = lane >> 5;
    LAS bf16_t* stg = (LAS bf16_t*)(lds + AT_OST) + wid * 2048;
#pragma unroll
    for (int r = 0; r < 16; ++r) { const int orow = crow(r, hi);
#pragma unroll
        for (int d0 = 0; d0 < 2; ++d0) stg[orow * 64 + d0 * 32 + r32] = (bf16_t)f2bf(o[d0][r]); }
    LDS_WAIT();
#pragma unroll
    for (int i = 0; i < 4; ++i) { const int row = i * 8 + (lane >> 3), ch = lane & 7; const u32x4 v = *(const LAS u32x4*)(stg + row * 64 + ch * 8); *(u32x4*)(rowptr(row) + ch * 8) = v; }
    LDS_WAIT();
}
__device__ __forceinline__ void row_factors(float f, float (&fr)[16], LAS unsigned char* lds, int wid, int lane) {
    LAS float* wsf = (LAS float*)(lds + AT_WSF) + wid * 64; const int r32 = lane & 31, hi = lane >> 5;
    if (hi == 0) wsf[r32] = f;
    LDS_WAIT();
#pragma unroll
    for (int r = 0; r < 16; ++r) fr[r] = wsf[crow(r, hi)];
    LDS_WAIT();
}
__device__ __forceinline__ float gain_bound(const float* ga, const float* gb, int lane) {
    const float a = wave_max(fabsf(ga[lane])), b = wave_max(fabsf(gb[lane]));
    return 8.f * a * b * LOG2E * 1.03f + 0.05f;
}

__device__ __forceinline__ void fox_unit(Frame& F, const Params& P, int b, int h, int qb, float qbound) {
    const int tid = F.tid, lane = F.lane, wid = F.wave, r32 = lane & 31, hi = lane >> 5;
    const bf16_t* Q = WSP(bf16_t, WS_Q); const bf16_t* Kb = WSP(bf16_t, WS_K); const bf16_t* Vb = WSP(bf16_t, WS_V); bf16_t* O = WSP(bf16_t, WS_O);
    const float* bias = WSP(float, WS_BIAS) + (size_t)(b * NH + h) * T; const u32x4* kaug = WSP(u32x4, WS_KAUG) + (size_t)(b * NH + h) * T;
    const size_t rowbase = (size_t)b * T; const int q0 = qb * 256; const int t = q0 + wid * 32 + r32;
    bf16x8 qr[4];
#pragma unroll
    for (int d0 = 0; d0 < 4; ++d0) qr[d0] = *(const bf16x8*)(Q + (rowbase + t) * D + h * 64 + d0 * 16 + hi * 8);
    bf16x8 qa = (bf16x8){0, 0, 0, 0, 0, 0, 0, 0};
    if (hi == 0) { const float cv = -(bias[t] + qbound); const unsigned c0 = f2bf(cv); const float r1 = cv - __builtin_bit_cast(float, c0 << 16); const unsigned c1 = f2bf(r1); const float r2 = r1 - __builtin_bit_cast(float, c1 << 16); const unsigned c2 = f2bf(r2);
        qa = (bf16x8){0x3F80, 0x3F80, 0x3F80, (short)c0, (short)c1, (short)c2, 0, 0}; }
    f32x16 o[2]; o[0] = splat16(0.f); o[1] = splat16(0.f); float l = 0.f;
    const int NT = 4 * qb + 4;
    int jmin;
    { const float thr = 2.f * qbound + 44.f, bq = bias[q0];
      const bool c0 = (lane < NT) && (bq - bias[64 * lane + 63] <= thr), c1 = (lane + 64 < NT) && (bq - bias[64 * (lane + 64) + 63] <= thr);
      const unsigned long long m0 = __ballot(c0), m1 = __ballot(c1);
      jmin = m0 ? (__ffsll((long long)m0) - 1) : (64 + __ffsll((long long)m1) - 1); }
    const int ntile = NT - jmin;
    int jmin_w;
    { const float thr = 2.f * qbound + 44.f, bq = bias[q0 + wid * 32];
      const bool c0 = (lane < NT) && (bq - bias[64 * lane + 63] <= thr), c1 = (lane + 64 < NT) && (bq - bias[64 * (lane + 64) + 63] <= thr);
      const unsigned long long m0 = __ballot(c0), m1 = __ballot(c1);
      jmin_w = m0 ? (__ffsll((long long)m0) - 1) : (m1 ? (64 + __ffsll((long long)m1) - 1) : NT); }
    const bf16_t* Kh = Kb + ((size_t)(b * NH + h) * T) * HD; const bf16_t* Vh = Vb + ((size_t)(b * NH + h) * T) * HD;
    tile_dma(Kh + (size_t)(NT - 1) * 4096, Vh + (size_t)(NT - 1) * 4096, F.lds, 0, tid, wid);
    u32x4 kan0 = kaug[(NT - 1) * 64 + r32], kan1 = kaug[(NT - 1) * 64 + 32 + r32];
    WAIT_BAR0();
    for (int jj = 0; jj < ntile; ++jj) {
        const int j = NT - 1 - jj;
        const u32x4 ka0 = kan0, ka1 = kan1;
        if (jj + 1 < ntile) { tile_dma(Kh + (size_t)(j - 1) * 4096, Vh + (size_t)(j - 1) * 4096, F.lds, (jj + 1) & 1, tid, wid); kan0 = kaug[(j - 1) * 64 + r32]; kan1 = kaug[(j - 1) * 64 + 32 + r32]; }
        const LAS unsigned char* Kbuf = F.lds + AT_K0 + (jj & 1) * 8192; const LAS unsigned char* Vbuf = F.lds + AT_V0 + (jj & 1) * 8192;
        if (j * 64 <= q0 + wid * 32 + 31 && j >= jmin_w) {
        f32x16 p0, p1; qk_tile(p0, p1, Kbuf, qr, r32, hi);
        p0 = __builtin_amdgcn_mfma_f32_32x32x16_bf16(__builtin_bit_cast(bf16x8, ka0), qa, p0, 0, 0, 0);
        p1 = __builtin_amdgcn_mfma_f32_32x32x16_bf16(__builtin_bit_cast(bf16x8, ka1), qa, p1, 0, 0, 0);
        VFrag vf; v_load(vf, Vbuf, lane);
        const bool band = j >= 4 * qb;
        if (band) {
#pragma unroll
            for (int r = 0; r < 16; ++r) {
                const int kv = j * 64 + crow(r, hi);
                const float e0 = __builtin_amdgcn_exp2f(p0[r]), e1 = __builtin_amdgcn_exp2f(p1[r]);
                p0[r] = kv > t ? 0.f : e0; p1[r] = kv + 32 > t ? 0.f : e1;
            }
        } else {
#pragma unroll
            for (int r = 0; r < 16; ++r) { p0[r] = __builtin_amdgcn_exp2f(p0[r]); p1[r] = __builtin_amdgcn_exp2f(p1[r]); }
        }
        l += psum(p0, p1);
        pv_tile(o, vf, p0, p1);
        }
        WAIT_BAR0();
    }
    l = half_swap_add(l);
    float fr[16]; row_factors(1.f / l, fr, F.lds, wid, lane);
#pragma unroll
    for (int r = 0; r < 16; ++r) { o[0][r] *= fr[r]; o[1][r] *= fr[r]; }
    bf16_t* Ow = O + (rowbase + q0 + wid * 32) * D + h * 64;
    store_o(o, F.lds, wid, lane, [&](int row) { return Ow + (size_t)row * D; });
    __syncthreads();
}
__device__ __forceinline__ void phase_fox_attn(Frame& F, const Params& P) {
    const float qbound = gain_bound(P.fox_qk_gain, P.fox_qk_gain + 64, F.lane);
    const int NU = NB * NH * 32;
    for (int i = 0; ; ++i) {
        int bh, qb;
        { const int u = i * F.G + F.vcu; if (u >= NU) break; bh = u >> 5; qb = (u + 8 * i) & 31; }
        fox_unit(F, P, bh >> 4, bh & 15, qb, qbound);
    }
}

template <class KP, class VP, class Body>
__device__ __forceinline__ void tile_loop(Frame& F, int nt, KP kptr, VP vptr, int stride, Body body) {
    const int tid = F.tid; (void)stride;
    tile_dma(kptr(0), vptr(0), F.lds, 0, tid, F.wave); WAIT_BAR0();
    for (int j = 0; j < nt; ++j) {
        if (j + 1 < nt) tile_dma(kptr(j + 1), vptr(j + 1), F.lds, (j + 1) & 1, tid, F.wave);
        body(j, (const LAS unsigned char*)(F.lds + AT_K0 + (j & 1) * 8192), (const LAS unsigned char*)(F.lds + AT_V0 + (j & 1) * 8192));
        WAIT_BAR0();
    }
}


template <class Fin>
__device__ __forceinline__ void attn_tile(f32x16 (&o)[2], float& l, const LAS unsigned char* Kbuf, const LAS unsigned char* Vbuf, const bf16x8 (&qr)[4], int lane, Fin fin) {
    const int r32 = lane & 31, hi = lane >> 5;
    const f32x16 z = {0.f, 0.f, 0.f, 0.f, 0.f, 0.f, 0.f, 0.f, 0.f, 0.f, 0.f, 0.f, 0.f, 0.f, 0.f, 0.f};
    const LAS unsigned char* kb = Kbuf + hi * 1024 + r32 * 16;
    const LAS char* vp = (const LAS char*)Vbuf + ((lane >> 4) & 1) * 32 + (lane & 3) * 8 + (4 * hi + ((lane & 15) >> 2)) * 64;
    bf16x8 kf[8];
#pragma unroll
    for (int d0 = 0; d0 < 4; ++d0) { kf[d0] = *(const LAS bf16x8*)(kb + d0 * 2048); kf[4 + d0] = *(const LAS bf16x8*)(kb + d0 * 2048 + 512); }
    __builtin_amdgcn_sched_barrier(0);
    f32x16 p0, p1;
#pragma unroll
    for (int d0 = 0; d0 < 4; ++d0) p0 = __builtin_amdgcn_mfma_f32_32x32x16_bf16(kf[d0], qr[d0], d0 ? p0 : z, 0, 0, 0);
#pragma unroll
    for (int d0 = 0; d0 < 4; ++d0) p1 = __builtin_amdgcn_mfma_f32_32x32x16_bf16(kf[4 + d0], qr[d0], d0 ? p1 : z, 0, 0, 0);
    s16x4 vlo[2][4], vhh[2][4];
#pragma unroll
    for (int d0 = 0; d0 < 2; ++d0)
#pragma unroll
        for (int ks = 0; ks < 4; ++ks) { vlo[d0][ks] = vtr(vp + d0 * 4096 + ks * 1024); vhh[d0][ks] = vtr(vp + d0 * 4096 + ks * 1024 + 512); }
    __builtin_amdgcn_sched_barrier(0);
#define AT_FIN(P, KOFF, PA, PB) \
        fin(P, KOFF); \
        { float s_ = 0.f; _Pragma("unroll") for (int r = 0; r < 16; ++r) s_ += P[r]; l += s_; } \
        u32x4 PA, PB; _Pragma("unroll") for (int i = 0; i < 4; ++i) { PA[i] = cvtpk(P[2 * i], P[2 * i + 1]); PB[i] = cvtpk(P[8 + 2 * i], P[9 + 2 * i]); }
#define AT_PV(PA, PB, KS0) \
        _Pragma("unroll") for (int d0 = 0; d0 < 2; ++d0) { \
            o[d0] = __builtin_amdgcn_mfma_f32_32x32x16_bf16(__builtin_bit_cast(bf16x8, PA), (bf16x8){vlo[d0][KS0][0], vlo[d0][KS0][1], vlo[d0][KS0][2], vlo[d0][KS0][3], vhh[d0][KS0][0], vhh[d0][KS0][1], vhh[d0][KS0][2], vhh[d0][KS0][3]}, o[d0], 0, 0, 0); \
            o[d0] = __builtin_amdgcn_mfma_f32_32x32x16_bf16(__builtin_bit_cast(bf16x8, PB), (bf16x8){vlo[d0][KS0 + 1][0], vlo[d0][KS0 + 1][1], vlo[d0][KS0 + 1][2], vlo[d0][KS0 + 1][3], vhh[d0][KS0 + 1][0], vhh[d0][KS0 + 1][1], vhh[d0][KS0 + 1][2], vhh[d0][KS0 + 1][3]}, o[d0], 0, 0, 0); }
    AT_FIN(p0, 0, pa0, pb0)
    __builtin_amdgcn_sched_barrier(0);
    AT_PV(pa0, pb0, 0)
    AT_FIN(p1, 32, pa1, pb1)
    __builtin_amdgcn_sched_barrier(0);
    AT_PV(pa1, pb1, 2)
#undef AT_FIN
#undef AT_PV
}

__device__ __forceinline__ void nsa_unit(Frame& F, int b, int g, int tb, float qb_c, float qb_s, float qb_w) {
    const int tid = F.tid, lane = F.lane, wid = F.wave, r32 = lane & 31, hi = lane >> 5;
    const int q0 = tb * 64, cur = tb, bg = b * NG + g;
    const int hh = r32 >> 3, tk = 8 * wid + (r32 & 7), t = q0 + tk, head = 4 * g + hh; const size_t row = (size_t)b * T + t;
    const bf16_t* Q = WSP(bf16_t, WS_Q); bf16_t* O = WSP(bf16_t, WS_O); const float* gates = WSP(float, WS_GATES) + row * 48 + head;
    const bf16_t* KC = WSP(bf16_t, WS_KC) + (size_t)bg * 512 * 64; const bf16_t* VC = WSP(bf16_t, WS_VC) + (size_t)bg * 512 * 64;
    const bf16_t* KS = WSP(bf16_t, WS_KS) + (size_t)bg * T * 64; const bf16_t* VS = WSP(bf16_t, WS_VS) + (size_t)bg * T * 64;
    const bf16_t* KW = WSP(bf16_t, WS_KW) + (size_t)bg * T * 64; const bf16_t* VW = WSP(bf16_t, WS_VW) + (size_t)bg * T * 64;
    LAS float* IMP = (LAS float*)(F.lds + AT_IMP); LAS unsigned* SELM = (LAS unsigned*)(F.lds + AT_SELM);
    bf16x8 qr[4];
#pragma unroll
    for (int d0 = 0; d0 < 4; ++d0) qr[d0] = *(const bf16x8*)(Q + row * D + head * 64 + d0 * 16 + hi * 8);
    const float g_c = gates[0], g_s = gates[16], g_w = gates[32];
    LAS float* OT = (LAS float*)(F.lds + AT_OT) + wid * 2048 + lane;
    float fr[16];

    const int NTc = (((q0 + 32) >> 4) >> 6) + 1; const int nmax = (t - 31) >> 4;
    const float sh_c = exp2f(-fmaxf(qb_c - 20.f, 0.f)), sh_s = exp2f(-fmaxf(qb_s - 20.f, 0.f)), sh_w = exp2f(-fmaxf(qb_w - 20.f, 0.f));
    float l_c = 0.f;
    const int nvis_all = (q0 - 31) >> 4, nvis_any = (q0 + 32) >> 4;
    auto fin_half = [&](f32x16& p, int nbase, float mul) {
        if (nbase + 31 <= nvis_all) {
#pragma unroll
            for (int r = 0; r < 16; ++r) p[r] = __builtin_amdgcn_exp2f(p[r]) * mul;
        } else if (nbase > nvis_any) {
#pragma unroll
            for (int r = 0; r < 16; ++r) p[r] = 0.f;
        } else {
#pragma unroll
            for (int r = 0; r < 16; ++r) p[r] = (nbase + crow(r, hi) <= nmax) ? __builtin_amdgcn_exp2f(p[r]) * mul : 0.f;
        }
    };
    tile_loop(F, NTc, [&](int j) { return KC + (size_t)j * 4096; }, [&](int j) { return VC + (size_t)j * 4096; }, 64, [&](int j, const LAS unsigned char* Kbuf, const LAS unsigned char* Vbuf) {
        f32x16 p0, p1; qk_tile(p0, p1, Kbuf, qr, r32, hi);
        fin_half(p0, j * 64, sh_c); fin_half(p1, j * 64 + 32, sh_c);
        l_c += psum(p0, p1);
    });
    l_c = half_swap_add(l_c);
    const float rl = l_c > 0.f ? sh_c / l_c : 0.f;
    {
        f32x16 o[2]; o[0] = splat16(0.f); o[1] = splat16(0.f); float carry = 0.f;
        tile_loop(F, NTc, [&](int j) { return KC + (size_t)j * 4096; }, [&](int j) { return VC + (size_t)j * 4096; }, 64, [&](int j, const LAS unsigned char* Kbuf, const LAS unsigned char* Vbuf) {
            f32x16 p0, p1; qk_tile(p0, p1, Kbuf, qr, r32, hi);
            VFrag vf; v_load(vf, Vbuf, lane);
            fin_half(p0, j * 64, rl); fin_half(p1, j * 64 + 32, rl);
            float rx03 = 0.f, rx13 = 0.f;
#pragma unroll
            for (int c = 0; c < 2; ++c) {
                float A[4], rX[4];
#pragma unroll
                for (int gq = 0; gq < 4; ++gq) {
                    const float x = 16.f * (c ? p1[4 * gq + 3] : p0[4 * gq + 3]);
                    A[gq] = 32.f * (c ? (p1[4 * gq] + p1[4 * gq + 1] + p1[4 * gq + 2]) : (p0[4 * gq] + p0[4 * gq + 1] + p0[4 * gq + 2])) + x;
                    rX[gq] = xor32_other(x);
                }
#pragma unroll
                for (int gq = 0; gq < 4; ++gq) {
                    const float prev = gq > 0 ? rX[gq - 1] : (c > 0 ? rx03 : carry);
                    float tot = A[gq] + (hi ? rX[gq] : prev);
                    tot = xor16_sum(xor8_sum(tot));
                    if (r32 < 8) IMP[tk * 128 + 16 * j + 8 * c + 2 * gq + hi] = tot;
                }
                if (c == 0) rx03 = rX[3]; else rx13 = rX[3];
            }
            carry = rx13;
            pv_tile(o, vf, p0, p1);
        });
        row_factors(g_c, fr, F.lds, wid, lane);
#pragma unroll
        for (int r = 0; r < 16; ++r) { OT[r * 64] = o[0][r] * fr[r]; OT[(16 + r) * 64] = o[1][r] * fr[r]; }
    }
    unsigned m0 = 0u, m1 = 0u, m2 = 0u, m3 = 0u;
    {
        LDS_WAIT(); asm volatile("" ::: "memory");
        const int tkk = lane >> 3, sub = lane & 7;
#define SETBIT(jx) do { const int j_ = (jx); const unsigned bit_ = 1u << (j_ & 31); const int w_ = j_ >> 5; m0 |= (w_ == 0) ? bit_ : 0u; m1 |= (w_ == 1) ? bit_ : 0u; m2 |= (w_ == 2) ? bit_ : 0u; m3 |= (w_ == 3) ? bit_ : 0u; } while (0)
        if (cur <= 15) { m0 = (cur == 31) ? 0xffffffffu : ((1u << (cur + 1)) - 1u); }
        else {
            SETBIT(0); SETBIT(cur); SETBIT(cur - 1);
            unsigned key[16];
#pragma unroll
            for (int i = 0; i < 16; ++i) { const int jx = sub + 8 * i; const unsigned kb_ = (__float_as_uint(IMP[(8 * wid + tkk) * 128 + jx]) & ~0x7Fu) | (unsigned)(127 - jx); key[i] = (jx >= 1 && jx <= cur - 2) ? kb_ : 0u; }
#pragma unroll 1
            for (int rnd = 0; rnd < SELTOP - 3; ++rnd) {
                unsigned best = 0u;
#pragma unroll
                for (int i = 0; i < 16; ++i) best = max(best, key[i]);
                best = max8_u32(best);
                const int bj = 127 - (int)(best & 0x7Fu);
                SETBIT(bj);
#pragma unroll
                for (int i = 0; i < 16; ++i) key[i] = (key[i] == best) ? 0u : key[i];
            }
        }
#undef SETBIT
        if (sub == 0) { LAS unsigned* d = SELM + (8 * wid + tkk) * 4; d[0] = m0; d[1] = m1; d[2] = m2; d[3] = m3; }
        LDS_WAIT(); asm volatile("" ::: "memory");
        const LAS unsigned* s = SELM + tk * 4; m0 = s[0]; m1 = s[1]; m2 = s[2]; m3 = s[3];
        LDS_WAIT();
    }
    {
        f32x16 o[2]; o[0] = splat16(0.f); o[1] = splat16(0.f); float l = 0.f;
        tile_loop(F, cur + 1, [&](int j) { return KS + (size_t)j * 4096; }, [&](int j) { return VS + (size_t)j * 4096; }, 64, [&](int j, const LAS unsigned char* Kbuf, const LAS unsigned char* Vbuf) {
            const unsigned w = j < 32 ? m0 : j < 64 ? m1 : j < 96 ? m2 : m3; const bool sel = (w >> (j & 31)) & 1u;
            if (__any(sel)) {
                const float sc = sel ? sh_s : 0.f; const bool diag = j == cur;
                attn_tile(o, l, Kbuf, Vbuf, qr, lane, [&](f32x16& p, int koff) {
#pragma unroll
                    for (int r = 0; r < 16; ++r) { float e = __builtin_amdgcn_exp2f(p[r]) * sc; if (diag) e = crow(r, hi) + koff > tk ? 0.f : e; p[r] = e; } });
            }
        });
        l = half_swap_add(l);
        row_factors(g_s / l, fr, F.lds, wid, lane);
#pragma unroll
        for (int r = 0; r < 16; ++r) { OT[r * 64] += o[0][r] * fr[r]; OT[(16 + r) * 64] += o[1][r] * fr[r]; }
    }
    {
        f32x16 o[2]; o[0] = splat16(0.f); o[1] = splat16(0.f); float l = 0.f;
        const int j0 = cur >= 8 ? cur - 8 : 0;
        tile_loop(F, cur - j0 + 1, [&](int j) { return KW + (size_t)(j0 + j) * 4096; }, [&](int j) { return VW + (size_t)(j0 + j) * 4096; }, 64, [&](int j, const LAS unsigned char* Kbuf, const LAS unsigned char* Vbuf) {
            const bool first = (j0 + j) == cur - 8, diag = (j0 + j) == cur;
            if (first) attn_tile(o, l, Kbuf, Vbuf, qr, lane, [&](f32x16& p, int koff) {
#pragma unroll
                for (int r = 0; r < 16; ++r) { const int kk = crow(r, hi) + koff; const float e = __builtin_amdgcn_exp2f(p[r]) * sh_w; p[r] = kk <= tk ? 0.f : e; } });
            else if (diag) attn_tile(o, l, Kbuf, Vbuf, qr, lane, [&](f32x16& p, int koff) {
#pragma unroll
                for (int r = 0; r < 16; ++r) { const int kk = crow(r, hi) + koff; const float e = __builtin_amdgcn_exp2f(p[r]) * sh_w; p[r] = kk > tk ? 0.f : e; } });
            else attn_tile(o, l, Kbuf, Vbuf, qr, lane, [&](f32x16& p, int koff) {
#pragma unroll
                for (int r = 0; r < 16; ++r) p[r] = __builtin_amdgcn_exp2f(p[r]) * sh_w; });
        });
        l = half_swap_add(l);
        row_factors(g_w / l, fr, F.lds, wid, lane);
#pragma unroll
        for (int r = 0; r < 16; ++r) { o[0][r] = OT[r * 64] + o[0][r] * fr[r]; o[1][r] = OT[(16 + r) * 64] + o[1][r] * fr[r]; }
        LDS_WAIT();
        bf16_t* Ob_ = O + ((size_t)b * T + q0 + 8 * wid) * D + 4 * g * 64;
        store_o(o, F.lds, wid, lane, [&](int r) { return Ob_ + (size_t)(r & 7) * D + (r >> 3) * 64; });
    }
    __syncthreads();
}
__device__ __forceinline__ void phase_nsa_attn(Frame& F, const Params& P) {
    const float qb_c = gain_bound(P.nsa_q_gain, P.kv_k_gain, F.lane), qb_s = gain_bound(P.nsa_q_gain, P.kv_k_gain + 64, F.lane), qb_w = gain_bound(P.nsa_q_gain, P.kv_k_gain + 128, F.lane);
    const int NU = NB * NG * 128;
    for (int i = 0; ; ++i) {
        int bg, tb;
        if (F.G == 256) { if (i >= 4) break; const int s = F.vcu & 31; bg = F.vcu >> 5; tb = (i == 0) ? s : (i == 1) ? 63 - s : (i == 2) ? 64 + s : 127 - s; }
        else { const int u = i * F.G + F.vcu; if (u >= NU) break; bg = u >> 7; tb = 127 - (u & 127); }
        nsa_unit(F, bg >> 2, bg & 3, tb, qb_c, qb_s, qb_w);
    }
}

struct CmpSched : BrowStd {
    const char* A; const char* Bt; int G, c;
    __device__ __forceinline__ bool next(int i, gm::Unit& u) const { if (i > 0 || c >= 32) return false; u.aux = c >> 4; u.pm = c & 15; u.pn = 0; u.cnt = 0; return true; }
    __device__ __forceinline__ const char* a_base() const { return A; }
    __device__ __forceinline__ unsigned a_off(const gm::Unit& u, int row) const { return (unsigned)u.aux * (unsigned)KV6_STRIDE + (unsigned)(u.pm * 256 + row) * 2048u; }
    __device__ __forceinline__ const char* b_base(const gm::Unit& u) const { return Bt + (size_t)u.aux * (256 * 2048 * 2); }
    __device__ __forceinline__ size_t hstepB() const { return (size_t)128 * 2048 * 2; }
};
struct EpiCompress {
    static constexpr bool AFTER_DRAIN = true;
    const float* cb1; const bf16_t* w2t; const float* kgain; const float* rope; bf16_t* KC; bf16_t* VC;
    __device__ __forceinline__ void operator()(const f32x4 (&)[2][2][4][2], const gm::Unit&, int, int, int, int) const {}
    __device__ __forceinline__ void fused(f32x4 (&acc)[2][2][4][2], const gm::Unit& u, int wr, int wc, int fr, int fq, LAS unsigned char* lds, int wid, int lane) const {
        const int j = u.aux;
#pragma unroll
        for (int bj = 0; bj < 2; ++bj) {
            const int col0 = 128 * bj + 32 * wc + 8 * fq; const f32x4 b0 = *(const f32x4*)(cb1 + j * 256 + col0), b1 = *(const f32x4*)(cb1 + j * 256 + col0 + 4);
            const int chunk = 16 * bj + 4 * wc + fq;
#pragma unroll
            for (int ai = 0; ai < 2; ++ai)
#pragma unroll
                for (int m = 0; m < 4; ++m) { const int row = 128 * ai + 64 * wr + 16 * m + fr; f32x4 h0 = acc[ai][bj][m][0] + b0, h1 = acc[ai][bj][m][1] + b1;
#pragma unroll
                    for (int jj = 0; jj < 4; ++jj) { h0[jj] = h0[jj] * __builtin_amdgcn_rcpf(1.f + __builtin_amdgcn_exp2f(-LOG2E * h0[jj])); h1[jj] = h1[jj] * __builtin_amdgcn_rcpf(1.f + __builtin_amdgcn_exp2f(-LOG2E * h1[jj])); }
                    *(LAS u32x4*)(lds + row * 512 + ((chunk ^ (row & 15)) * 16)) = pack8(h0, h1); }
        }
        LDS_WAIT(); __builtin_amdgcn_s_barrier(); asm volatile("" ::: "memory");
        const int r32 = lane & 31, hi = lane >> 5; const int trow = 32 * wid + r32;
        f32x16 a2[2]; a2[0] = splat16(0.f); a2[1] = splat16(0.f);
        const bf16_t* wb = w2t + (size_t)j * 64 * 256;
#pragma unroll 4
        for (int ks = 0; ks < 16; ++ks) {
            const bf16x8 hb = *(const LAS bf16x8*)(lds + trow * 512 + (((2 * ks + hi) ^ (trow & 15)) * 16));
#pragma unroll
            for (int cb = 0; cb < 2; ++cb) { const bf16x8 wa = *(const bf16x8*)(wb + (size_t)(32 * cb + r32) * 256 + 16 * ks + 8 * hi);
                a2[cb] = __builtin_amdgcn_mfma_f32_32x32x16_bf16(wa, hb, a2[cb], 0, 0, 0); }
        }
        const int n = (u.pm & 1) * 256 + trow, bg = u.pm >> 1;
        if (j == 0) {
            float s = 0.f;
#pragma unroll
            for (int cb = 0; cb < 2; ++cb)
#pragma unroll
                for (int r = 0; r < 16; ++r) s += a2[cb][r] * a2[cb][r];
            s = half_swap_add(s);
            const float rs = __builtin_amdgcn_rsqf(s * (1.f / 64.f) + EPS);
#pragma unroll
            for (int cb = 0; cb < 2; ++cb)
#pragma unroll
                for (int r = 0; r < 16; ++r) a2[cb][r] *= rs * kgain[32 * cb + crow(r, hi)];
            const int pos = 16 * n + 31; const float* rp = rope + (size_t)(pos < T ? pos : T - 1) * 16;
#pragma unroll
            for (int r = 0; r < 4; ++r) { const int i = r + 4 * hi; const float c = rp[2 * i], sn = rp[2 * i + 1]; const float x1 = a2[0][r], x2 = a2[0][r + 4];
                a2[0][r] = x1 * c - x2 * sn; a2[0][r + 4] = x2 * c + x1 * sn; }
        }
        bf16_t* hb = (j == 0 ? KC : VC) + (size_t)bg * 512 * 64;
        const bool zero = n >= NCMP;
#pragma unroll
        for (int cb = 0; cb < 2; ++cb)
#pragma unroll
            for (int rq = 0; rq < 4; ++rq) { u32x2 o; o.x = pk2(a2[cb][4 * rq], a2[cb][4 * rq + 1]); o.y = pk2(a2[cb][4 * rq + 2], a2[cb][4 * rq + 3]); if (zero) { o.x = 0u; o.y = 0u; }
                const int d = 32 * cb + 8 * rq + 4 * hi;
                *(u32x2*)(hb + (j == 0 ? kimg_off(n, d) : vimg_off(n, d))) = o; }
    }
};

constexpr int N_PHASES = 21;
#if defined(__HIP_DEVICE_COMPILE__)
typedef const __attribute__((address_space(4))) Params* kparams_t;
__device__ __forceinline__ kparams_t kargs() { kparams_t p = (kparams_t)__builtin_amdgcn_kernarg_segment_ptr(); asm volatile("" : "+s"(p)); return p; }
#define KP(f) (kargs()->f)
#else
#define KP(f) (Params{}.f)
#endif
#define LOADP() Params P; { P.x = KP(x); P.p = KP(p); P.attn_norm = KP(attn_norm); P.ffn_norm = KP(ffn_norm); P.ple_norm = KP(ple_norm); P.ple_gate_w = KP(ple_gate_w); P.ple_proj_w = KP(ple_proj_w); \
    P.router_w = KP(router_w); P.router_b = KP(router_b); P.w_gu = KP(w_gu); P.b_gu = KP(b_gu); P.w_down = KP(w_down); P.b_down = KP(b_down); P.fox_w_in = KP(fox_w_in); P.fox_b_f = KP(fox_b_f); \
    P.fox_qk_gain = KP(fox_qk_gain); P.fox_w_out = KP(fox_w_out); P.kv_norm = KP(kv_norm); P.kv_w = KP(kv_w); P.kv_k_gain = KP(kv_k_gain); P.cmp_pos = KP(cmp_pos); P.cmp_w1 = KP(cmp_w1); P.cmp_w2 = KP(cmp_w2); \
    P.nsa_w_in = KP(nsa_w_in); P.nsa_q_gain = KP(nsa_q_gain); P.nsa_w_out = KP(nsa_w_out); P.out = KP(out); P.ws = KP(ws); P.ph_lo = 0; P.ph_hi = 0; } F.ws = P.ws

#define XB_TMO      128
#define XB_XCNT(j)  (256  + 64 * (j))
#define XB_XSUB(j)  (1280 + 64 * (j))
#define XB_XGEN(j)  (2304 + 64 * (j))
#define XB_TOP      3328
#define XB_TOPGEN   3392
#define XB_SPIN_CAP (1u << 22)
__device__ __forceinline__ unsigned xb_ld(unsigned* p)              { return __hip_atomic_load(p, __ATOMIC_RELAXED, __HIP_MEMORY_SCOPE_AGENT); }
__device__ __forceinline__ unsigned xb_add(unsigned* p, unsigned v) { return __hip_atomic_fetch_add(p, v, __ATOMIC_RELAXED, __HIP_MEMORY_SCOPE_AGENT); }
__device__ __forceinline__ unsigned xb_xcc_id() { return (unsigned)__builtin_amdgcn_s_getreg((3 << 11) | 20) & 0xFu; }
#define XB_SPIN(cond, bar) do { unsigned _sp = 0; while (cond) { __builtin_amdgcn_s_sleep(1); \
    if ((++_sp & 255u) == 0u) { if (xb_ld(&(bar)[XB_TMO])) break; if (_sp > XB_SPIN_CAP) { atomicAdd(&(bar)[XB_TMO], 1u); break; } } } } while (0)
__device__ __forceinline__ void xcd_barrier_post(unsigned* bar, int tid) { if (tid == 0) (void)xb_add(&bar[XB_XCNT(xb_xcc_id())], 1u); }
__device__ __forceinline__ void xcd_barrier_complete(unsigned* bar, unsigned x, unsigned& nloc, unsigned& nx) {
    const unsigned G = gridDim.x;
    unsigned sum, cnt, mine, sp = 0u;
    for (;;) {
        sum = 0u; cnt = 0u; mine = 0u;
#pragma unroll
        for (unsigned j = 0; j < 16; ++j) { const unsigned c = xb_ld(&bar[XB_XCNT(j)]); sum += c; cnt += (c > 0u) ? 1u : 0u; mine = (j == x) ? c : mine; }
        if (sum == G) break;
        __builtin_amdgcn_s_sleep(1);
        if ((++sp & 255u) == 0u) { if (xb_ld(&bar[XB_TMO])) break; if (sp > XB_SPIN_CAP) { atomicAdd(&bar[XB_TMO], 1u); break; } }
    }
    nloc = mine > 0u ? mine : 1u; nx = cnt > 0u ? cnt : 1u;
}
__device__ __forceinline__ void xcd_barrier(unsigned* bar, volatile LAS unsigned* st, int tid) {
    asm volatile("s_waitcnt vmcnt(0)" ::: "memory");
    __syncthreads();
    if (tid == 0) {
        const unsigned x = xb_xcc_id();
        __builtin_amdgcn_s_waitcnt(0);
        unsigned nloc = st[0], nx = st[1];
        if (nloc == 0u) { xcd_barrier_complete(bar, x, nloc, nx); st[0] = nloc; st[1] = nx; }
        const unsigned old = xb_add(&bar[XB_XSUB(x)], 1u);
        const unsigned gen = old / nloc;
        if (old + 1u == (gen + 1u) * nloc) {
            __builtin_amdgcn_fence(__ATOMIC_RELEASE, "agent");
            asm volatile("s_waitcnt vmcnt(0)" ::: "memory");
            const unsigned og = xb_add(&bar[XB_TOP], 1u);
            const unsigned tg = og / nx;
            if (og + 1u == (tg + 1u) * nx) xb_add(&bar[XB_TOPGEN], 1u);
            else XB_SPIN(xb_ld(&bar[XB_TOPGEN]) == tg, bar);
            __builtin_amdgcn_fence(__ATOMIC_ACQUIRE, "agent");
            xb_add(&bar[XB_XGEN(x)], 1u);
            asm volatile("s_waitcnt vmcnt(0)" ::: "memory");
        } else {
            XB_SPIN(xb_ld(&bar[XB_XGEN(x)]) == gen, bar);
            __builtin_amdgcn_fence(__ATOMIC_ACQUIRE, "agent");
            asm volatile("s_waitcnt vmcnt(0)" ::: "memory");
        }
    }
    __syncthreads();
}

__device__ __forceinline__ void pp_gemm(Frame& F, int l) {
    __syncthreads();
    int K5 = 256; asm volatile("" : "+s"(K5));
    DenseSched<BrowStd> S; S.init(WSP(bf16_t, WS_PBF) + (size_t)l * M * PLE, 512, WSP(bf16_t, WS_WPLEP) + (size_t)l * D * PLE, (size_t)256 * 256 * 2, (size_t)128 * 256 * 2, M, 4, F.G, F.bx);
    EpiBf16 E{WSP(bf16_t, WS_PP) + (size_t)l * M * D, D};
    gm::gemm_phase(F.lds, K5, S, E, F.tid);
}

extern __shared__ __attribute__((aligned(16))) unsigned char lds_raw[];
template <int PH>
__device__ __forceinline__ void run_phase(int wv) {
    Frame F;
    int tid_ = wv * 64 + lane_id_v(); asm volatile("" : "+v"(tid_));
    F.lds = (LAS unsigned char*)lds_raw; F.tid = tid_; F.lane = F.tid & 63; F.wave = __builtin_amdgcn_readfirstlane(F.tid >> 6);
    int bx = blockIdx.x; asm volatile("" : "+s"(bx));
    F.G = gridDim.x; F.vcu = (F.G % 8 == 0) ? (bx % 8) * (F.G / 8) + bx / 8 : bx; F.bx = bx;
    F.gw = F.vcu * NWAVES + F.wave; F.NGW = F.G * NWAVES;
    LOADP();
    bf16_t* XB = WSP(bf16_t, WS_XB);
    constexpr int layer = (PH >= 16) ? 1 : 0;
    constexpr int ph = (PH >= 16) ? PH - 10 : PH;
    LAS int* tstart = (LAS int*)(F.lds + LDS_MISC); LAS int* ecnt = tstart + 64;
    if constexpr (PH == 0) { phase_prologue(F, P); }
    else if constexpr (PH == 1) { phase_fox_pre(F, P); }
    else if constexpr (PH == 2) {
        if (F.vcu < NB * NH) fox_scan(F, F.vcu);
        DenseSched<BrowHead> S; S.init(WSP(bf16_t, WS_XN), 2048, WSP(bf16_t, WS_WFOXIN), (size_t)256 * 1024 * 2, (size_t)32 * 1024 * 2, M, 12, F.G, F.bx);
        EpiFoxQKV E{WSP(bf16_t, WS_Q), P.fox_qk_gain};
        gm::gemm_phase(F.lds, 1024, S, E, F.tid);
    }
    else if constexpr (PH == 3) { phase_fox_attn(F, P); }
    else if constexpr (PH == 4) {
        DenseSched<BrowStd> S; S.init(WSP(bf16_t, WS_O), 2048, WSP(bf16_t, WS_WFOXOUT), (size_t)256 * 1024 * 2, (size_t)128 * 1024 * 2, M, 4, F.G, F.bx);
        EpiResid<float> E{P.x, XB};
        gm::gemm_phase(F.lds, 1024, S, E, F.tid);
        pp_gemm(F, 0);
    }
    else if constexpr (PH == 5) { }
    else if constexpr (ph == 6) {
#if defined(PROBE_ROUTE)
        phase_moe_route(F, P, layer, XB, 2 + layer); __syncthreads();
#endif
        phase_moe_route(F, P, layer, XB); }
    else if constexpr (ph == 7) {
        const int ntot = moe_tables(F, layer, tstart, ecnt);
        MoeSched S; S.A = (const char*)WSP(unsigned char, WS_XN8); S.list = WSP(int, WS_LIST); S.Bt = (const char*)(WSP(unsigned char, WS_WGU) + (size_t)layer * NE * 2048 * 1024); S.estride = (size_t)2048 * 1024;
        S.tstepB_ = (size_t)128 * 1024; S.hstepB_ = (size_t)1024 * 1024; S.npn = 8; S.G = F.G; S.c = F.vcu; S.ntot = ntot; S.gather = true; S.tstart = tstart; S.ecnt = ecnt;
        EpiSwiglu E{WSP(unsigned char, WS_H), P.b_gu + (size_t)layer * NE * 2048};
        int K8 = 512; asm volatile("" : "+s"(K8)); gm::gemm_phase<true>(F.lds, K8, S, E, F.tid);
    }
    else if constexpr (ph == 8) {
        const int ntot = moe_tables(F, layer, tstart, ecnt);
        MoeSched S; S.A = (const char*)WSP(unsigned char, WS_H); S.list = nullptr; S.Bt = (const char*)(WSP(unsigned char, WS_WDN) + (size_t)layer * NE * 1024 * 1024); S.estride = (size_t)1024 * 1024;
        S.tstepB_ = (size_t)256 * 1024; S.hstepB_ = (size_t)128 * 1024; S.npn = 4; S.G = F.G; S.c = F.vcu; S.ntot = ntot; S.gather = false; S.tstart = tstart; S.ecnt = ecnt;
        EpiDown E{WSP(unsigned char, WS_Y), P.b_down + (size_t)layer * NE * D, WSP(float, WS_GL)};
        int K8 = 512; asm volatile("" : "+s"(K8)); gm::gemm_phase<true>(F.lds, K8, S, E, F.tid);
    }
    else if constexpr (ph == 9) { phase_moe_combine(F, layer, XB); }
    else if constexpr (ph == 10) {
        DenseSched<BrowStd> S; S.init(WSP(unsigned char, WS_XN8), 1024, WSP(unsigned char, WS_WPLEG) + (size_t)layer * D * D, (size_t)256 * 1024, (size_t)128 * 1024, M, 4, F.G, F.bx);
        int K8 = 512; asm volatile("" : "+s"(K8));
        if constexpr (layer == 1) { EpiPle<float> E{XB, P.out, WSP(bf16_t, WS_PP) + (size_t)layer * M * D}; gm::gemm_phase<true>(F.lds, K8, S, E, F.tid); }
        else { EpiPle<bf16_t> E{XB, XB, WSP(bf16_t, WS_PP) + (size_t)layer * M * D}; gm::gemm_phase<true>(F.lds, K8, S, E, F.tid); }
    }
    else if constexpr (PH == 11) { phase_nsa_pre(F); }
    else if constexpr (PH == 12) {
        DenseSched<BrowHead> S; S.init(WSP(bf16_t, WS_XB), 2048, WSP(bf16_t, WS_WNSA), (size_t)256 * 1024 * 2, (size_t)32 * 1024 * 2, M, 10, F.G, F.bx);
        EpiNsaKVQ E{WSP(bf16_t, WS_Q), WSP(bf16_t, WS_ZK), P.kv_k_gain, P.nsa_q_gain, WSP(float, WS_ROPE), WSP(float, WS_RSTD)};
        gm::gemm_phase(F.lds, 1024, S, E, F.tid);
        if (F.G == 256 && F.bx >= 128) { __syncthreads(); convert_moe_l1(F, P, F.bx - 128, 128, 0, L1_SPLIT); }

    }
    else if constexpr (PH == 13) {
        CmpSched S; S.A = (const char*)WSP(bf16_t, WS_ZK); S.Bt = (const char*)WSP(bf16_t, WS_WC1); S.G = F.G; S.c = F.vcu;
        EpiCompress E{WSP(float, WS_CB1), WSP(bf16_t, WS_WC2), P.kv_k_gain, WSP(float, WS_ROPE), WSP(bf16_t, WS_KC), WSP(bf16_t, WS_VC)};
        if (F.vcu < 32 || F.G <= 32) gm::gemm_phase(F.lds, 2048, S, E, F.tid);
        const int lo = (F.G == 256) ? L1_SPLIT : 0;
        if (F.vcu >= 32) convert_moe_l1(F, P, F.vcu - 32, F.G - 32, lo, L1_ITEMS);
        else if (F.G <= 32) convert_moe_l1(F, P, F.vcu, F.G, lo, L1_ITEMS);
    }
    else if constexpr (PH == 14) { phase_nsa_attn(F, P); }
    else if constexpr (PH == 15) {
        DenseSched<BrowStd> S; S.init(WSP(bf16_t, WS_O), 2048, WSP(bf16_t, WS_WNSAOUT), (size_t)256 * 1024 * 2, (size_t)128 * 1024 * 2, M, 4, F.G, F.bx);
        EpiResid<bf16_t> E{XB, XB};
        gm::gemm_phase(F.lds, 1024, S, E, F.tid);
        pp_gemm(F, 1);
    }
}
template <int K, int HI>
__device__ __forceinline__ void run_range(int wv) {
    if constexpr (K == 5) { if constexpr (K + 1 < HI) run_range<K + 1, HI>(wv); return; }
    run_phase<K>(wv);
    if constexpr ((REPEAT_MASK >> K) & 1u) { int tid = wv * 64 + lane_id_v(); asm volatile("" : "+v"(tid)); xcd_barrier((unsigned*)(KP(ws) + WS_CTL) + CW_BAR, (volatile LAS unsigned*)((LAS unsigned char*)lds_raw + LDS_MISC + 512), tid); run_phase<K>(wv); }
    if constexpr (K + 1 < HI) {
        { int tid = wv * 64 + lane_id_v(); asm volatile("" : "+v"(tid)); xcd_barrier((unsigned*)(KP(ws) + WS_CTL) + CW_BAR, (volatile LAS unsigned*)((LAS unsigned char*)lds_raw + LDS_MISC + 512), tid); }
        run_range<K + 1, HI>(wv);
    }
}
template <int LO, int HI>
__global__ void __launch_bounds__(NTHREADS, 2) __attribute__((target("no-packed-fp32-ops"))) mega(Params P_) {
    const int wv = __builtin_amdgcn_readfirstlane((int)threadIdx.x >> 6);
    if constexpr (HI - LO > 1) {
        if (KP(ph_hi) < 0) cg::this_grid().sync();
        int tid = wv * 64 + lane_id_v(); asm volatile("" : "+v"(tid));
        volatile LAS unsigned* st = (volatile LAS unsigned*)((LAS unsigned char*)lds_raw + LDS_MISC + 512);
        if (tid < 2) st[tid] = 0u;
        __syncthreads();
        xcd_barrier_post((unsigned*)(KP(ws) + WS_CTL) + CW_BAR, tid);
    }
    run_range<LO, HI>(wv);
}

#if N_LAUNCH_MODE == 1
#define FULLK (mega<0, N_PHASES>)
static void set_attrs() { (void)hipFuncSetAttribute((const void*)FULLK, hipFuncAttributeMaxDynamicSharedMemorySize, LDS_BYTES); }
#else
#define FULLK (mega<0, 1>)
template <int K> static void set_attr1() { (void)hipFuncSetAttribute((const void*)(mega<K, K + 1>), hipFuncAttributeMaxDynamicSharedMemorySize, LDS_BYTES); if constexpr (K + 1 < N_PHASES) set_attr1<K + 1>(); }
static void set_attrs() { set_attr1<0>(); }
template <int K> static void launch_all(const Params& P, int grid, hipStream_t stream) {
    hipLaunchKernelGGL((mega<K, K + 1>), dim3(grid), dim3(NTHREADS), LDS_BYTES, stream, P);
    if constexpr (K + 1 < N_PHASES) launch_all<K + 1>(P, grid, stream);
}
#endif
extern "C" void kernel_launch(void* const* d_in, const int* in_sizes, int n_in, void* d_out, int out_size, void* d_ws, size_t ws_size, hipStream_t stream) {
    static int grid = 0;
    if (grid == 0) {
        if (n_in != 26 || ws_size < WS_END) { fprintf(stderr, "kernel_launch: unexpected inputs (n_in %d, ws %zu, need %zu)\n", n_in, ws_size, (size_t)WS_END); grid = -1; return; }
        int dev = 0, cus = 0, per_cu = 0;
        hipGetDevice(&dev); hipDeviceGetAttribute(&cus, hipDeviceAttributeMultiprocessorCount, dev);
        set_attrs();
        hipOccupancyMaxActiveBlocksPerMultiprocessor(&per_cu, (const void*)FULLK, NTHREADS, LDS_BYTES);
        (void)hipGetLastError();
        if (per_cu < 1) { fprintf(stderr, "kernel_launch: occupancy query says %d blocks/CU\n", per_cu); grid = -1; return; }
        grid = cus;
    }
    if (grid < 0) return;
    hipMemsetAsync((char*)d_ws + WS_CTL, 0, CTL_BYTES, stream);
    Params P{};
    const float** pp = (const float**)&P;
    for (int i = 0; i < 26; ++i) pp[i] = (const float*)d_in[i];
    P.out = (float*)d_out; P.ws = (unsigned char*)d_ws;
#if N_LAUNCH_MODE == 1
    P.ph_lo = 0; P.ph_hi = N_PHASES;
    void* args[] = {&P};
    hipError_t e = hipLaunchCooperativeKernel((const void*)FULLK, dim3(grid), dim3(NTHREADS), args, LDS_BYTES, stream);
    if (e != hipSuccess) fprintf(stderr, "cooperative launch failed: %s (grid %d)\n", hipGetErrorString(e), grid);
#else
    launch_all<0>(P, grid, stream);
#endif
}
```

```cpp
#include <hip/hip_runtime.h>
#include <hip/hip_cooperative_groups.h>
#include <cstdint>
#include <cstdio>
namespace cg = cooperative_groups;

#ifndef REPEAT_MASK
#define REPEAT_MASK 0u
#endif
#ifndef N_LAUNCH_MODE
#define N_LAUNCH_MODE 1
#endif

#define LAS __attribute__((address_space(3)))
typedef unsigned short bf16_t;
typedef short bf16x8 __attribute__((ext_vector_type(8)));
typedef short s16x4 __attribute__((ext_vector_type(4)));
typedef float f32x2 __attribute__((ext_vector_type(2)));
typedef float f32x4 __attribute__((ext_vector_type(4)));
typedef float f32x16 __attribute__((ext_vector_type(16)));
typedef unsigned u32x2 __attribute__((ext_vector_type(2)));
typedef unsigned u32x4 __attribute__((ext_vector_type(4)));
typedef int i32x8 __attribute__((ext_vector_type(8)));
typedef int i32x4 __attribute__((ext_vector_type(4)));

constexpr int NB = 2, T = 8192, D = 1024, M = NB * T, NH = 16, HD = 64, NG = 4, HPG = 4;
constexpr int PLE = 256, NE = 32, TOPK = 4, FF = 1024;
constexpr int NCMP = 511, NSEL = 128, SELTOP = 16, WIN = 512;
constexpr int FOXN = 3 * NH * HD + NH;
constexpr int NSAN = NH * HD + 3 * NH;
constexpr int KVN = 6 * NG * HD;
constexpr float EPS = 1e-6f;
constexpr float LOG2E = 1.4426950408889634f;
constexpr float C2 = 0.125f * LOG2E;
constexpr int MOE_ROWS = M * TOPK + NE * 256;
constexpr int NWAVES = 8, NTHREADS = 512;

constexpr size_t MiB = 1u << 20;
constexpr size_t al(size_t x) { return (x + 4095) & ~(size_t)4095; }
constexpr size_t WS_CTL = 0, CTL_BYTES = 1 * MiB;
constexpr size_t WS_ROPE = WS_CTL + CTL_BYTES;
constexpr size_t WS_WFT = WS_ROPE + (size_t)T * 8 * 2 * 4;
constexpr size_t WS_WRT = WS_WFT + 32 * 1024 * 4;
constexpr size_t WS_WGT = WS_WRT + 2 * 32 * 1024 * 4;
constexpr size_t WS_CB1 = WS_WGT + 64 * 1024 * 4;
constexpr size_t WS_RSTD = al(WS_CB1 + 2 * 256 * 4);
constexpr size_t WS_LOGF = WS_RSTD + (size_t)M * 4;
constexpr size_t WS_BIAS = WS_LOGF + (size_t)NB * NH * T * 4;
constexpr size_t WS_KAUG = WS_BIAS + (size_t)NB * NH * T * 4;
constexpr size_t WS_GATES = WS_KAUG + (size_t)NB * NH * T * 16;
constexpr size_t WS_TOKINFO = WS_GATES + (size_t)M * 48 * 4;
constexpr size_t WS_LIST = WS_TOKINFO + (size_t)M * 4 * 4;
constexpr size_t WS_GL = WS_LIST + (size_t)NE * M * 4;
constexpr size_t WS_WFOXIN = al(WS_GL + (size_t)NE * M * 4);
constexpr size_t WS_WFOXOUT = WS_WFOXIN + (size_t)3072 * 1024 * 2;
constexpr size_t WS_WNSA = WS_WFOXOUT + (size_t)1024 * 1024 * 2;
constexpr size_t WS_WNSAOUT = WS_WNSA + (size_t)2560 * 1024 * 2;
constexpr size_t WS_WPLEG = WS_WNSAOUT + (size_t)1024 * 1024 * 2;
constexpr size_t WS_WPLEP = WS_WPLEG + (size_t)2 * 1024 * 1024 * 2;
constexpr size_t WS_WC1 = WS_WPLEP + (size_t)2 * 1024 * 256 * 2;
constexpr size_t WS_WC2 = WS_WC1 + (size_t)2 * 256 * 2048 * 2;
constexpr size_t WS_WGU = al(WS_WC2 + (size_t)2 * 64 * 256 * 2);
constexpr size_t WS_WDN = WS_WGU + (size_t)2 * 32 * 2048 * 1024 * 2;
constexpr size_t WS_XB = WS_WDN + (size_t)2 * 32 * 1024 * 1024 * 2;
constexpr size_t WS_XN = WS_XB + (size_t)M * D * 4;
constexpr size_t WS_Q = WS_XN + (size_t)M * D * 2;
constexpr size_t WS_K = WS_Q + (size_t)M * D * 2;
constexpr size_t WS_V = WS_K + (size_t)M * D * 2;
constexpr size_t WS_O = WS_V + (size_t)M * D * 2;
constexpr size_t NSA_HEADBUF = (size_t)NB * NG * T * HD * 2;
constexpr size_t KV6_STRIDE = NSA_HEADBUF + 8192;
constexpr size_t WS_ZK = WS_O + (size_t)M * D * 2;
constexpr size_t WS_ZV = WS_ZK + KV6_STRIDE;
constexpr size_t WS_KS = WS_ZV + KV6_STRIDE;
constexpr size_t WS_VS = WS_KS + KV6_STRIDE;
constexpr size_t WS_KW = WS_VS + KV6_STRIDE;
constexpr size_t WS_VW = WS_KW + KV6_STRIDE;
constexpr size_t WS_KC = WS_VW + KV6_STRIDE;
constexpr size_t WS_VC = WS_KC + (size_t)8 * 512 * 64 * 2;
constexpr size_t WS_PBF = WS_VC + (size_t)8 * 512 * 64 * 2;
constexpr size_t WS_PP = WS_PBF + (size_t)2 * M * PLE * 2;
constexpr size_t WS_H = WS_PP + (size_t)2 * M * D * 2;
constexpr size_t WS_Y = WS_H + (size_t)MOE_ROWS * FF * 2;
constexpr size_t WS_XN8 = WS_Y + (size_t)MOE_ROWS * D * 2;
constexpr size_t WS_END = WS_XN8 + (size_t)M * D;

constexpr int CW_CNT = 16384, CNT_STRIDE = 64;
constexpr int CW_BAR = 4096;

constexpr int RING_BYTES = 131072;
constexpr int LDS_BYTES = 147456;
constexpr int LDS_MISC = LDS_BYTES - 2048;

__device__ __forceinline__ unsigned f2bf(float f) { unsigned u = __builtin_bit_cast(unsigned, f); return (u + 0x7fffu + ((u >> 16) & 1u)) >> 16; }
typedef __bf16 bf16x2_t __attribute__((ext_vector_type(2)));
__device__ __forceinline__ unsigned pk2(float lo, float hi) { f32x2 v = {lo, hi}; bf16x2_t b = __builtin_convertvector(v, bf16x2_t); return __builtin_bit_cast(unsigned, b); }
__device__ __forceinline__ unsigned pk4_fp8(float a, float b, float c, float d) { int w = __builtin_amdgcn_cvt_pk_fp8_f32(a, b, 0, false); w = __builtin_amdgcn_cvt_pk_fp8_f32(c, d, w, true); return (unsigned)w; }
constexpr float W8_SCALE = 32.f, W8_INV = 1.f / 32.f, Y8_SCALE = 16.f, Y8_INV = 1.f / 16.f;
__device__ __forceinline__ f32x4 ld4(const float* p) { return *(const f32x4*)p; }
__device__ __forceinline__ f32x4 ld4(const bf16_t* p) { const u32x2 w = *(const u32x2*)p; return (f32x4){__builtin_bit_cast(float, w.x << 16), __builtin_bit_cast(float, w.x & 0xffff0000u), __builtin_bit_cast(float, w.y << 16), __builtin_bit_cast(float, w.y & 0xffff0000u)}; }
__device__ __forceinline__ void ld8(const float* p, f32x4& a, f32x4& b) { a = *(const f32x4*)p; b = *(const f32x4*)(p + 4); }
__device__ __forceinline__ void ld8(const bf16_t* p, f32x4& a, f32x4& b) { const u32x4 w = *(const u32x4*)p;
    a = (f32x4){__builtin_bit_cast(float, w.x << 16), __builtin_bit_cast(float, w.x & 0xffff0000u), __builtin_bit_cast(float, w.y << 16), __builtin_bit_cast(float, w.y & 0xffff0000u)};
    b = (f32x4){__builtin_bit_cast(float, w.z << 16), __builtin_bit_cast(float, w.z & 0xffff0000u), __builtin_bit_cast(float, w.w << 16), __builtin_bit_cast(float, w.w & 0xffff0000u)}; }
__device__ __forceinline__ void st8(float* p, const f32x4 a, const f32x4 b) { *(f32x4*)p = a; *(f32x4*)(p + 4) = b; }
__device__ __forceinline__ void st4(float* p, const f32x4 v) { *(f32x4*)p = v; }
__device__ __forceinline__ void st4(bf16_t* p, const f32x4 v) { u32x2 o; o.x = pk2(v[0], v[1]); o.y = pk2(v[2], v[3]); *(u32x2*)p = o; }
__device__ __forceinline__ float bf2f(unsigned short b) { return __builtin_bit_cast(float, (unsigned)b << 16); }
#define DPPF(v, ctrl, rm) __uint_as_float(__builtin_amdgcn_update_dpp(0u, __float_as_uint(v), ctrl, rm, 0xF, true))
__device__ __forceinline__ float wave_sum(float v) {
    v += DPPF(v, 0xB1, 0xF); v += DPPF(v, 0x4E, 0xF); v += DPPF(v, 0x141, 0xF); v += DPPF(v, 0x140, 0xF);
    { auto r = __builtin_amdgcn_permlane16_swap(__float_as_uint(v), __float_as_uint(v), false, false); v = __uint_as_float(r[0]) + __uint_as_float(r[1]); }
    { auto r = __builtin_amdgcn_permlane32_swap(__float_as_uint(v), __float_as_uint(v), false, false); v = __uint_as_float(r[0]) + __uint_as_float(r[1]); }
    return v;
}
__device__ __forceinline__ float wave_max(float v) {
    v = fmaxf(v, DPPF(v, 0xB1, 0xF)); v = fmaxf(v, DPPF(v, 0x4E, 0xF)); v = fmaxf(v, DPPF(v, 0x141, 0xF)); v = fmaxf(v, DPPF(v, 0x140, 0xF));
    { auto r = __builtin_amdgcn_permlane16_swap(__float_as_uint(v), __float_as_uint(v), false, false); v = fmaxf(__uint_as_float(r[0]), __uint_as_float(r[1])); }
    { auto r = __builtin_amdgcn_permlane32_swap(__float_as_uint(v), __float_as_uint(v), false, false); v = fmaxf(__uint_as_float(r[0]), __uint_as_float(r[1])); }
    return v;
}
__device__ __forceinline__ float wave_scan_f(float v) {
    v += DPPF(v, 0x111, 0xF); v += DPPF(v, 0x112, 0xF); v += DPPF(v, 0x114, 0xF); v += DPPF(v, 0x118, 0xF);
    v += DPPF(v, 0x142, 0xA); v += DPPF(v, 0x143, 0xC);
    return v;
}
__device__ __forceinline__ f32x16 splat16z() { f32x16 r;
#pragma unroll
    for (int i = 0; i < 16; ++i) r[i] = 0.f; return r; }
__device__ __forceinline__ int lane_id() { return (int)__builtin_amdgcn_mbcnt_hi(~0u, __builtin_amdgcn_mbcnt_lo(~0u, 0u)); }
__device__ __forceinline__ int lane_id_v() { int l; asm volatile("v_mbcnt_lo_u32_b32 %0, -1, 0\n\tv_mbcnt_hi_u32_b32 %0, -1, %0" : "=v"(l)); return l; }
__device__ __forceinline__ float xor32_other(float v) { auto r = __builtin_amdgcn_permlane32_swap(__float_as_uint(v), __float_as_uint(v), false, false); return __uint_as_float(((lane_id() >> 5) & 1) ? r[0] : r[1]); }
__device__ __forceinline__ float xor32_sum(float v) { auto r = __builtin_amdgcn_permlane32_swap(__float_as_uint(v), __float_as_uint(v), false, false); return __uint_as_float(r[0]) + __uint_as_float(r[1]); }
__device__ __forceinline__ float xor16_sum(float v) { auto r = __builtin_amdgcn_permlane16_swap(__float_as_uint(v), __float_as_uint(v), false, false); return __uint_as_float(r[0]) + __uint_as_float(r[1]); }
__device__ __forceinline__ float xor8_sum(float v) { return v + __uint_as_float(__builtin_amdgcn_update_dpp(0u, __float_as_uint(v), 0x128, 0xF, 0xF, true)); }
__device__ __forceinline__ unsigned max8_u32(unsigned v) {
    v = max(v, (unsigned)__builtin_amdgcn_update_dpp(0u, v, 0xB1, 0xF, 0xF, true));
    v = max(v, (unsigned)__builtin_amdgcn_update_dpp(0u, v, 0x4E, 0xF, 0xF, true));
    v = max(v, (unsigned)__builtin_amdgcn_update_dpp(0u, v, 0x141, 0xF, 0xF, true));
    return v;
}
__device__ __forceinline__ float xor16_other(float v) { auto r = __builtin_amdgcn_permlane16_swap(__float_as_uint(v), __float_as_uint(v), false, false); return __uint_as_float(((lane_id() >> 4) & 1) ? r[0] : r[1]); }
#define LDS_WAIT() asm volatile("s_waitcnt lgkmcnt(0)" ::: "memory")
#define VM_WAIT() asm volatile("s_waitcnt vmcnt(0)" ::: "memory")

struct Params {
    const float* x; const float* p; const float* attn_norm; const float* ffn_norm; const float* ple_norm;
    const float* ple_gate_w; const float* ple_proj_w; const float* router_w; const float* router_b;
    const float* w_gu; const float* b_gu; const float* w_down; const float* b_down;
    const float* fox_w_in; const float* fox_b_f; const float* fox_qk_gain; const float* fox_w_out;
    const float* kv_norm; const float* kv_w; const float* kv_k_gain; const float* cmp_pos; const float* cmp_w1; const float* cmp_w2;
    const float* nsa_w_in; const float* nsa_q_gain; const float* nsa_w_out;
    float* out; unsigned char* ws;
    int ph_lo, ph_hi;
};

namespace gm {
template <bool F8> struct FragT { struct A4 { bf16x8 v[4][2]; }; struct B2 { bf16x8 v[2][2]; }; };
template <> struct FragT<true> { struct A4 { i32x8 v[4]; }; struct B2 { i32x8 v[2]; }; };
constexpr int BM = 256, BK = 64, HALF = 128, HTB = HALF * BK * 2, STAGE_BYTES = 8 * HTB;
__host__ __device__ __forceinline__ int lds_byte(int r, int c) { const int st = (r >> 4) * 2 + (c >> 5), rr = r & 15, cc = c & 31, ob = rr * 64 + cc * 2; return st * 1024 + (ob ^ (((ob >> 9) & 1) << 5)); }
__host__ __device__ __forceinline__ void stage_rc(int b, int& R, int& C) { const int st = b / 1024, sb = b % 1024, swz = sb ^ (((sb >> 9) & 1) << 5); R = (st >> 1) * 16 + swz / 64; C = (st & 1) * 32 + (swz % 64) / 2; }
__host__ __device__ __forceinline__ int perm32(int rho) { const int n = rho >> 4, i = rho & 15; return 8 * (i >> 2) + 4 * n + (i & 3); }

struct Unit { int pm, pn, aux, cnt; };

template <bool F8 = false, class Epi, class Sched>
__device__ __forceinline__ void gemm_phase(LAS unsigned char* lds, const int K, const Sched& S, const Epi& E, const int tid) {
    const int wid = __builtin_amdgcn_readfirstlane(tid >> 6), lane = tid & 63, wr = wid >> 2, wc = wid & 3, fr = lane & 15, fq = lane >> 4;
    const int nt = K / BK;
    int Rl0, Cl0; stage_rc(tid * 16, Rl0, Cl0);
    const int Rl[2] = {Rl0, Rl0 + 64}, Cl[2] = {Cl0, Cl0}; unsigned voffB[2];
#pragma unroll
    for (int i = 0; i < 2; ++i) voffB[i] = (unsigned)(Sched::brow(Rl[i]) * K + Cl[i]) * 2u;
    const size_t kstep = (size_t)(BK * 2);
    const size_t hstepB = S.hstepB();
    const unsigned ldsw = (unsigned)wid * 1024u;
    const int aoff = lds_byte(wr * 64 + fr, F8 ? fq * 16 : fq * 8), boff = lds_byte(wc * 32 + fr, F8 ? fq * 16 : fq * 8);
    const int aoff1 = aoff + (F8 ? 16 : 1024), boff1 = boff + (F8 ? 16 : 1024);
#define G_SA(b, h) (((b) * 2 + (h)) * HTB)
#define G_SB(b, h) ((4 + (b) * 2 + (h)) * HTB)
#define G_STAGE(bufoff, gbase, v0, v1) do { \
        __builtin_amdgcn_global_load_lds((const unsigned*)((const char*)(gbase) + (v0)), (LAS unsigned*)(lds + (bufoff) + ldsw), 16, 0, 0); \
        __builtin_amdgcn_global_load_lds((const unsigned*)((const char*)(gbase) + (v1)), (LAS unsigned*)(lds + (bufoff) + ldsw + 8192), 16, 0, 0); } while (0)
#define G_LDA(dst, b, h) do { _Pragma("unroll") for (int m = 0; m < 4; ++m) { \
        if constexpr (F8) { const i32x4 lo_ = *(const LAS i32x4*)(lds + G_SA(b, h) + aoff + m * 2048), hi_ = *(const LAS i32x4*)(lds + G_SA(b, h) + aoff1 + m * 2048); dst.v[m] = __builtin_shufflevector(lo_, hi_, 0, 1, 2, 3, 4, 5, 6, 7); } \
        else { _Pragma("unroll") for (int k = 0; k < 2; ++k) dst.v[m][k] = *(const LAS bf16x8*)(lds + G_SA(b, h) + (k ? aoff1 : aoff) + m * 2048); } } } while (0)
#define G_LDB(dst, b, h) do { _Pragma("unroll") for (int n = 0; n < 2; ++n) { \
        if constexpr (F8) { const i32x4 lo_ = *(const LAS i32x4*)(lds + G_SB(b, h) + boff + n * 2048), hi_ = *(const LAS i32x4*)(lds + G_SB(b, h) + boff1 + n * 2048); dst.v[n] = __builtin_shufflevector(lo_, hi_, 0, 1, 2, 3, 4, 5, 6, 7); } \
        else { _Pragma("unroll") for (int k = 0; k < 2; ++k) dst.v[n][k] = *(const LAS bf16x8*)(lds + G_SB(b, h) + (k ? boff1 : boff) + n * 2048); } } } while (0)
#define G_MMA(ai, bj, At, Bt) do { __builtin_amdgcn_s_setprio(1); _Pragma("unroll") for (int m = 0; m < 4; ++m) _Pragma("unroll") for (int n = 0; n < 2; ++n) { \
        if constexpr (F8) { asm volatile("v_mfma_f32_16x16x128_f8f6f4 %0, %1, %2, %0" : "+v"(acc[ai][bj][m][n]) : "v"(Bt.v[n]), "v"(At.v[m])); } \
        else { _Pragma("unroll") for (int k = 0; k < 2; ++k) acc[ai][bj][m][n] = __builtin_amdgcn_mfma_f32_16x16x32_bf16(Bt.v[n][k], At.v[m][k], acc[ai][bj][m][n], 0, 0, 0); } } \
        __builtin_amdgcn_s_setprio(0); } while (0)
#define G_WAIT_V(n) asm volatile("s_waitcnt vmcnt(" #n ")" ::: "memory")
#define G_WAIT_L(n) asm volatile("s_waitcnt lgkmcnt(" #n ")" ::: "memory")
#define G_BAR __builtin_amdgcn_s_barrier()
#define G_SCHED __builtin_amdgcn_sched_barrier(0)
    Unit cur, nxt; int ui = 0;
    if (!S.next(0, cur)) return;
    f32x4 acc[2][2][4][2];
#pragma unroll
    for (int a = 0; a < 2; ++a)
#pragma unroll
        for (int b = 0; b < 2; ++b)
#pragma unroll
            for (int m = 0; m < 4; ++m)
#pragma unroll
                for (int n = 0; n < 2; ++n) acc[a][b][m][n] = (f32x4){0.f, 0.f, 0.f, 0.f};
    typedef typename FragT<F8>::A4 FA; typedef typename FragT<F8>::B2 FB;
    FA At; FB B0, B1;
    const char* const Ab = S.a_base();
    const char* cB = S.b_base(cur);
    unsigned cA00 = S.a_off(cur, Rl[0]) + Cl[0] * 2, cA01 = S.a_off(cur, Rl[1]) + Cl[1] * 2, cA10 = S.a_off(cur, 128 + Rl[0]) + Cl[0] * 2, cA11 = S.a_off(cur, 128 + Rl[1]) + Cl[1] * 2;
    G_STAGE(G_SB(0, 0), cB, voffB[0], voffB[1]); G_STAGE(G_SB(0, 1), cB + hstepB, voffB[0], voffB[1]); G_STAGE(G_SA(0, 0), Ab, cA00, cA01); G_STAGE(G_SA(0, 1), Ab, cA10, cA11);
    if (wr == 1) G_BAR;
    G_WAIT_V(2); G_BAR;
    G_STAGE(G_SB(1, 0), cB + kstep, voffB[0], voffB[1]); G_STAGE(G_SA(1, 0), Ab + kstep, cA00, cA01); G_STAGE(G_SB(1, 1), cB + hstepB + kstep, voffB[0], voffB[1]);
    G_WAIT_V(6); G_BAR;
    for (;;) {
        const bool has_next = S.next(ui + 1, nxt);
        const char* nB = has_next ? S.b_base(nxt) : cB;
        unsigned nA00 = cA00, nA01 = cA01, nA10 = cA10, nA11 = cA11;
        if (has_next) { nA00 = S.a_off(nxt, Rl[0]) + Cl[0] * 2; nA01 = S.a_off(nxt, Rl[1]) + Cl[1] * 2; nA10 = S.a_off(nxt, 128 + Rl[0]) + Cl[0] * 2; nA11 = S.a_off(nxt, 128 + Rl[1]) + Cl[1] * 2; }
        for (int t = 0; t < nt; t += 2) {
            const bool last = (t == nt - 2);
            const char* a1 = Ab + (size_t)(t + 1) * kstep;
            const char* a2 = last ? Ab : Ab + (size_t)(t + 2) * kstep; const char* b2 = last ? nB : cB + (size_t)(t + 2) * kstep;
            const char* a3 = a2 + kstep; const char* b3 = b2 + kstep;
            const unsigned x00 = last ? nA00 : cA00, x01 = last ? nA01 : cA01, x10 = last ? nA10 : cA10, x11 = last ? nA11 : cA11;
            G_LDB(B0, 0, 0); G_LDB(B1, 0, 1); G_SCHED; G_LDA(At, 0, 0); G_STAGE(G_SA(1, 1), a1, cA10, cA11);
            G_WAIT_V(8); G_WAIT_L(0); G_BAR; G_MMA(0, 0, At, B0); G_MMA(0, 1, At, B1); G_BAR; G_SCHED;
            G_LDA(At, 0, 1); G_STAGE(G_SB(0, 0), b2, voffB[0], voffB[1]); G_STAGE(G_SB(0, 1), b2 + hstepB, voffB[0], voffB[1]); G_STAGE(G_SA(0, 0), a2, x00, x01);
            G_WAIT_V(8); G_WAIT_L(0); G_BAR; G_MMA(1, 0, At, B0); G_MMA(1, 1, At, B1); G_BAR; G_SCHED;
            G_LDB(B0, 1, 0); G_LDB(B1, 1, 1); G_SCHED; G_LDA(At, 1, 0); G_STAGE(G_SA(0, 1), a2, x10, x11);
            G_WAIT_V(8); G_WAIT_L(0); G_BAR; G_MMA(0, 0, At, B0); G_MMA(0, 1, At, B1); G_BAR; G_SCHED;
            G_LDA(At, 1, 1); G_STAGE(G_SB(1, 0), b3, voffB[0], voffB[1]); G_STAGE(G_SB(1, 1), b3 + hstepB, voffB[0], voffB[1]); G_STAGE(G_SA(1, 0), a3, x00, x01);
            G_WAIT_V(8); G_WAIT_L(0); G_BAR; G_MMA(1, 0, At, B0); G_MMA(1, 1, At, B1); G_BAR; G_SCHED;
        }
        if constexpr (F8) asm volatile("s_nop 15\n\ts_nop 15" ::: "memory");
        if (wr == 0) G_BAR;
        if constexpr (!Epi::AFTER_DRAIN) { E(acc, cur, wr, wc, fr, fq); }
        if (!has_next) break;
#pragma unroll
        for (int a = 0; a < 2; ++a)
#pragma unroll
            for (int b = 0; b < 2; ++b)
#pragma unroll
                for (int m = 0; m < 4; ++m)
#pragma unroll
                    for (int n = 0; n < 2; ++n) acc[a][b][m][n] = (f32x4){0.f, 0.f, 0.f, 0.f};
        cur = nxt; cB = nB; cA00 = nA00; cA01 = nA01; cA10 = nA10; cA11 = nA11; ++ui;
        if (wr == 1) G_BAR;
    }
    G_WAIT_V(0);
    G_BAR;
    if constexpr (Epi::AFTER_DRAIN) { E.fused(acc, cur, wr, wc, fr, fq, lds, wid, lane); }
#undef G_SA
#undef G_SB
#undef G_STAGE
#undef G_LDA
#undef G_LDB
#undef G_MMA
#undef G_WAIT_V
#undef G_WAIT_L
#undef G_BAR
#undef G_SCHED
}
}

constexpr int NXCD = 8, WGM = 8;
struct BrowStd  { static __host__ __device__ __forceinline__ int brow(int R) { return (R & ~31) + gm::perm32(R & 31); } };
struct BrowHead { static __host__ __device__ __forceinline__ int brow(int R) { return 64 * (R >> 5) + gm::perm32(R & 31); } };

template <class BR>
struct DenseSched : BR {
    const char* A; unsigned lda_bytes; const char* Bt; size_t tstepB_, hstepB_, bsplit = 0; int nM, nN, nwg, G, c;
    __device__ __forceinline__ void init(const void* A_, unsigned lda_b, const void* Bt_, size_t tstepB, size_t hstepB, int Mrows, int ntn, int G_, int c_) {
        A = (const char*)A_; lda_bytes = lda_b; Bt = (const char*)Bt_; tstepB_ = tstepB; hstepB_ = hstepB; nM = Mrows / 256; nN = ntn; nwg = nM * nN; G = G_; c = c_; }
    __device__ __forceinline__ bool next(int i, gm::Unit& u) const {
        const long L = (long)i * G + c; if (L >= nwg) return false;
        int wgid = (int)L; { const int q = nwg / NXCD, r = nwg % NXCD, xcd = wgid % NXCD, off = wgid / NXCD; wgid = (xcd < r ? xcd * (q + 1) : r * (q + 1) + (xcd - r) * q) + off; }
        const int nig = WGM * nN, gid = wgid / nig, fm = gid * WGM, gsz = (nM - fm) < WGM ? (nM - fm) : WGM;
        u.pm = fm + ((wgid % nig) % gsz); u.pn = (wgid % nig) / gsz; u.aux = 0; u.cnt = 0; return true;
    }
    __device__ __forceinline__ const char* a_base() const { return A; }
    __device__ __forceinline__ unsigned a_off(const gm::Unit& u, int row) const { return (unsigned)(u.pm * 256 + row) * lda_bytes; }
    __device__ __forceinline__ const char* b_base(const gm::Unit& u) const { return Bt + (size_t)(u.pm >> 6) * bsplit + (size_t)u.pn * tstepB_; }
    __device__ __forceinline__ size_t hstepB() const { return hstepB_; }
};

struct MoeSched : BrowStd {
    const char* A; const int* list; const char* Bt; size_t estride, tstepB_, hstepB_; int npn, G, c, ntot; bool gather;
    const LAS int* tstart; const LAS int* ecnt;
    __device__ __forceinline__ bool next(int i, gm::Unit& u) const {
        if (G == 256) {
            const int x = c >> 5; int L = i * 32 + (c & 31);
#pragma unroll 1
            for (int k = 0; k < 4; ++k) {
                const int e = x + 8 * k, t0 = __builtin_amdgcn_readfirstlane(tstart[e]), nt = __builtin_amdgcn_readfirstlane(tstart[e + 1]) - t0, units = nt * npn;
                if (L < units) { const int quad = nt * 4, pnh = L / quad, r2 = L - pnh * quad, rt = r2 >> 2; u.pn = pnh * 4 + (r2 & 3); u.pm = t0 + rt; u.aux = e; u.cnt = rt * 256; return true; }
                L -= units;
            }
            return false;
        }
        const long L = (long)i * G + c; if (L >= (long)ntot * npn) return false;
        const int rt = (int)(L / npn); u.pn = (int)(L % npn); u.pm = rt;
        int e = 0;
#pragma unroll 1
        for (int k = 1; k < NE; ++k) e = (__builtin_amdgcn_readfirstlane(tstart[k]) <= rt) ? k : e;
        u.aux = e; u.cnt = (rt - __builtin_amdgcn_readfirstlane(tstart[e])) * 256; return true;
    }
    __device__ __forceinline__ const char* a_base() const { return A; }
    __device__ __forceinline__ unsigned a_off(const gm::Unit& u, int row) const {
        if (gather) { const int last = __builtin_amdgcn_readfirstlane(ecnt[u.aux]) - 1; const int pos = min(u.cnt + row, last); return (unsigned)list[u.aux * M + pos] * 1024u; }
        return (unsigned)(u.pm * 256 + row) * 1024u;
    }
    __device__ __forceinline__ const char* b_base(const gm::Unit& u) const { return Bt + (size_t)u.aux * estride + (size_t)u.pn * tstepB_; }
    __device__ __forceinline__ size_t hstepB() const { return hstepB_; }
};

__device__ __forceinline__ size_t kimg_off(int t, int d) { return (size_t)(t >> 6) * 4096 + (d >> 3) * 512 + (t & 63) * 8 + (d & 7); }
__device__ __forceinline__ size_t vimg_off(int t, int d) { return (size_t)(t >> 6) * 4096 + (d >> 5) * 2048 + (t & 63) * 32 + (d & 31); }
__device__ __forceinline__ u32x4 pack8(const f32x4 a, const f32x4 b) { u32x4 w; w.x = pk2(a[0], a[1]); w.y = pk2(a[2], a[3]); w.z = pk2(b[0], b[1]); w.w = pk2(b[2], b[3]); return w; }
__device__ __forceinline__ void st8(bf16_t* p, const f32x4 a, const f32x4 b) { *(u32x4*)p = pack8(a, b); }

struct EpiFoxQKV {
    static constexpr bool AFTER_DRAIN = false;
    bf16_t* Q; const float* gain;
    __device__ __forceinline__ void operator()(const f32x4 (&acc)[2][2][4][2], const gm::Unit& u, int wr, int wc, int fr, int fq) const {
        const int hidx = 4 * u.pn + wc, kind = hidx >> 4, head = hidx & 15;
        bf16_t* base = Q + (size_t)kind * ((size_t)M * D) + head * 64 + 8 * fq;
        f32x4 g[2][2];
#pragma unroll
        for (int bj = 0; bj < 2; ++bj)
#pragma unroll
            for (int n = 0; n < 2; ++n) g[bj][n] = (kind < 2) ? *(const f32x4*)(gain + kind * 64 + 32 * bj + 8 * fq + 4 * n) : (f32x4){1.f, 1.f, 1.f, 1.f};
        const float sc = (kind == 0) ? C2 : 1.f;
#pragma unroll
        for (int ai = 0; ai < 2; ++ai)
#pragma unroll
            for (int m = 0; m < 4; ++m) {
                const int row = u.pm * 256 + ai * 128 + wr * 64 + m * 16 + fr;
                float rs = 1.f;
                if (kind < 2) {
                    float s = 0.f;
#pragma unroll
                    for (int bj = 0; bj < 2; ++bj)
#pragma unroll
                        for (int n = 0; n < 2; ++n) { const f32x4 v = acc[ai][bj][m][n]; s += (v[0] * v[0] + v[1] * v[1]) + (v[2] * v[2] + v[3] * v[3]); }
                    s += __shfl_xor(s, 16); s += __shfl_xor(s, 32);
                    rs = __builtin_amdgcn_rsqf(s * (1.f / 64.f) + EPS) * sc;
                }
                const int bb = row >> 13, tt = row & (T - 1);
                bf16_t* hb = Q + (size_t)kind * ((size_t)M * D) + ((size_t)(bb * NH + head) * T) * HD;
#pragma unroll
                for (int bj = 0; bj < 2; ++bj) { bf16_t* dst = kind == 0 ? base + (size_t)row * D + 32 * bj : hb + (kind == 1 ? kimg_off(tt, 32 * bj + 8 * fq) : vimg_off(tt, 32 * bj + 8 * fq));
                    *(u32x4*)dst = pack8(acc[ai][bj][m][0] * rs * g[bj][0], acc[ai][bj][m][1] * rs * g[bj][1]); }
            }
    }
};

struct EpiNsaKVQ {
    static constexpr bool AFTER_DRAIN = false;
    bf16_t* Q; bf16_t* kv6; const float* kgain; const float* qgain; const float* rope; const float* rstd;
    __device__ __forceinline__ void operator()(const f32x4 (&acc)[2][2][4][2], const gm::Unit& u, int wr, int wc, int fr, int fq) const {
        const int hidx = 4 * u.pn + wc;
        const bool isq = hidx >= 24; const int j = hidx >> 2, g = hidx & 3;
        const bool donorm = isq || j == 2 || j == 4;
        const float* gp = isq ? qgain : (kgain + (j == 2 ? 64 : 128));
        f32x4 gn[2][2];
#pragma unroll
        for (int bj = 0; bj < 2; ++bj)
#pragma unroll
            for (int n = 0; n < 2; ++n) gn[bj][n] = donorm ? *(const f32x4*)(gp + 32 * bj + 8 * fq + 4 * n) : (f32x4){1.f, 1.f, 1.f, 1.f};
        const float sc = isq ? C2 : 1.f;
#pragma unroll
        for (int ai = 0; ai < 2; ++ai)
#pragma unroll
            for (int m = 0; m < 4; ++m) {
                const int row = u.pm * 256 + ai * 128 + wr * 64 + m * 16 + fr; const int b = row >> 13, t = row & (T - 1);
                f32x4 v[2][2]; const float rr_ = rstd[row];
#pragma unroll
                for (int bj = 0; bj < 2; ++bj)
#pragma unroll
                    for (int n = 0; n < 2; ++n) v[bj][n] = acc[ai][bj][m][n] * rr_;
                if (donorm) {
                    float s = 0.f;
#pragma unroll
                    for (int bj = 0; bj < 2; ++bj)
#pragma unroll
                        for (int n = 0; n < 2; ++n) { const f32x4 w = v[bj][n]; s += (w[0] * w[0] + w[1] * w[1]) + (w[2] * w[2] + w[3] * w[3]); }
                    s += __shfl_xor(s, 16); s += __shfl_xor(s, 32);
                    const float rs = __builtin_amdgcn_rsqf(s * (1.f / 64.f) + EPS);
#pragma unroll
                    for (int bj = 0; bj < 2; ++bj)
#pragma unroll
                        for (int n = 0; n < 2; ++n) v[bj][n] = v[bj][n] * rs * gn[bj][n];
#pragma unroll
                    for (int n = 0; n < 2; ++n) {
                        const f32x4 cs0 = *(const f32x4*)(rope + ((size_t)t * 8 + 4 * n) * 2), cs1 = *(const f32x4*)(rope + ((size_t)t * 8 + 4 * n) * 2 + 4);
                        const float cc[4] = {cs0[0], cs0[2], cs1[0], cs1[2]}, ss[4] = {cs0[1], cs0[3], cs1[1], cs1[3]};
#pragma unroll
                        for (int jj = 0; jj < 4; ++jj) {
                            const float own = v[0][n][jj], oth = __shfl_xor(own, 16);
                            const float r0 = own * cc[jj] - oth * ss[jj], r1 = own * cc[jj] + oth * ss[jj];
                            v[0][n][jj] = fq == 0 ? r0 : (fq == 1 ? r1 : own);
                        }
                    }
#pragma unroll
                    for (int bj = 0; bj < 2; ++bj)
#pragma unroll
                        for (int n = 0; n < 2; ++n) v[bj][n] = v[bj][n] * sc;
                }
                bf16_t* hb = kv6 + (size_t)j * (KV6_STRIDE / 2) + ((size_t)(b * NG + g) * T) * HD;
#pragma unroll
                for (int bj = 0; bj < 2; ++bj) { const int d = 32 * bj + 8 * fq;
                    bf16_t* dst = isq ? (Q + (size_t)row * D + (hidx - 24) * 64 + d) : (j < 2 ? hb + (size_t)t * HD + d : ((j & 1) ? hb + vimg_off(t, d) : hb + kimg_off(t, d)));
                    *(u32x4*)dst = pack8(v[bj][0], v[bj][1]); }
            }
    }
};

template <class TB>
struct EpiResid {
    static constexpr bool AFTER_DRAIN = false;
    const TB* base; bf16_t* out;
    __device__ __forceinline__ void operator()(const f32x4 (&acc)[2][2][4][2], const gm::Unit& u, int wr, int wc, int fr, int fq) const {
        const int col0 = u.pn * 256 + wc * 32 + 8 * fq;
#pragma unroll
        for (int ai = 0; ai < 2; ++ai)
#pragma unroll
            for (int m = 0; m < 4; ++m) { const size_t off = (size_t)(u.pm * 256 + ai * 128 + wr * 64 + m * 16 + fr) * D + col0;
#pragma unroll
                for (int bj = 0; bj < 2; ++bj) { f32x4 b0, b1; ld8(base + off + bj * 128, b0, b1);
                    *(u32x4*)(out + off + bj * 128) = pack8(b0 + acc[ai][bj][m][0], b1 + acc[ai][bj][m][1]); } }
    }
};

struct EpiBf16 {
    static constexpr bool AFTER_DRAIN = false;
    bf16_t* O; int ldc;
    __device__ __forceinline__ void operator()(const f32x4 (&acc)[2][2][4][2], const gm::Unit& u, int wr, int wc, int fr, int fq) const {
        const int col0 = u.pn * 256 + wc * 32 + 8 * fq;
#pragma unroll
        for (int ai = 0; ai < 2; ++ai)
#pragma unroll
            for (int m = 0; m < 4; ++m) { bf16_t* rowp = O + (size_t)(u.pm * 256 + ai * 128 + wr * 64 + m * 16 + fr) * ldc + col0;
#pragma unroll
                for (int bj = 0; bj < 2; ++bj) *(u32x4*)(rowp + bj * 128) = pack8(acc[ai][bj][m][0], acc[ai][bj][m][1]); }
    }
};

template <class TO>
struct EpiPle {
    static constexpr bool AFTER_DRAIN = false;
    const bf16_t* xin; TO* out; const bf16_t* pp;
    __device__ __forceinline__ void operator()(const f32x4 (&acc)[2][2][4][2], const gm::Unit& u, int wr, int wc, int fr, int fq) const {
        const int col0 = u.pn * 256 + wc * 32 + 8 * fq;
#pragma unroll
        for (int ai = 0; ai < 2; ++ai)
#pragma unroll
            for (int m = 0; m < 4; ++m) { const size_t off = (size_t)(u.pm * 256 + ai * 128 + wr * 64 + m * 16 + fr) * D + col0;
#pragma unroll
                for (int bj = 0; bj < 2; ++bj) {
                    f32x4 b[2], pv[2], o[2]; ld8(xin + off + bj * 128, b[0], b[1]); ld8(pp + off + bj * 128, pv[0], pv[1]);
#pragma unroll
                    for (int n = 0; n < 2; ++n)
#pragma unroll
                        for (int jj = 0; jj < 4; ++jj) { const float sg = __builtin_amdgcn_rcpf(1.f + __builtin_amdgcn_exp2f(acc[ai][bj][m][n][jj] * (-W8_INV * LOG2E))); o[n][jj] = b[n][jj] + sg * pv[n][jj]; }
                    st8(out + off + bj * 128, o[0], o[1]); } }
    }
};

struct EpiSwiglu {
    static constexpr bool AFTER_DRAIN = false;
    unsigned char* Hb; const float* bgu;
    __device__ __forceinline__ void operator()(const f32x4 (&acc)[2][2][4][2], const gm::Unit& u, int wr, int wc, int fr, int fq) const {
        const int f0 = u.pn * 128 + wc * 32 + 8 * fq; const float* bb = bgu + (size_t)u.aux * 2048 + f0;
        f32x4 ba[2], bu[2];
#pragma unroll
        for (int n = 0; n < 2; ++n) { ba[n] = *(const f32x4*)(bb + 4 * n); bu[n] = *(const f32x4*)(bb + 1024 + 4 * n); }
#pragma unroll
        for (int ai = 0; ai < 2; ++ai)
#pragma unroll
            for (int m = 0; m < 4; ++m) { unsigned char* rowp = Hb + (size_t)(u.pm * 256 + ai * 128 + wr * 64 + m * 16 + fr) * FF + f0;
                f32x4 y[2];
#pragma unroll
                for (int n = 0; n < 2; ++n) { const f32x4 a4 = acc[ai][0][m][n] * W8_INV + ba[n], u4 = acc[ai][1][m][n] * W8_INV + bu[n];
#pragma unroll
                    for (int jj = 0; jj < 4; ++jj) { const float a = fminf(a4[jj], 7.f), uu = fminf(fmaxf(u4[jj], -7.f), 7.f); y[n][jj] = (uu + 1.f) * (a * __builtin_amdgcn_rcpf(1.f + __builtin_amdgcn_exp2f(a * (-1.702f * LOG2E)))); } }
                u32x2 o8; o8.x = pk4_fp8(y[0][0], y[0][1], y[0][2], y[0][3]); o8.y = pk4_fp8(y[1][0], y[1][1], y[1][2], y[1][3]); *(u32x2*)rowp = o8; }
    }
};

struct EpiDown {
    static constexpr bool AFTER_DRAIN = false;
    unsigned char* Y; const float* bdn; const float* gl;
    __device__ __forceinline__ void operator()(const f32x4 (&acc)[2][2][4][2], const gm::Unit& u, int wr, int wc, int fr, int fq) const {
        const int col0 = u.pn * 256 + wc * 32 + 8 * fq; const float* bb = bdn + (size_t)u.aux * D + col0;
        f32x4 bv[2][2];
#pragma unroll
        for (int bj = 0; bj < 2; ++bj)
#pragma unroll
            for (int n = 0; n < 2; ++n) bv[bj][n] = *(const f32x4*)(bb + bj * 128 + 4 * n);
#pragma unroll
        for (int ai = 0; ai < 2; ++ai)
#pragma unroll
            for (int m = 0; m < 4; ++m) { const int r = ai * 128 + wr * 64 + m * 16 + fr; int pos = u.cnt + r; pos = pos < M ? pos : M - 1;
                const float gt = gl[(size_t)u.aux * M + pos];
                unsigned char* rowp = Y + (size_t)(u.pm * 256 + r) * D + col0; const float gy = gt * Y8_SCALE;
#pragma unroll
                for (int bj = 0; bj < 2; ++bj) { const f32x4 y0 = (acc[ai][bj][m][0] * W8_INV + bv[bj][0]) * gy, y1 = (acc[ai][bj][m][1] * W8_INV + bv[bj][1]) * gy;
                    u32x2 o8; o8.x = pk4_fp8(y0[0], y0[1], y0[2], y0[3]); o8.y = pk4_fp8(y1[0], y1[1], y1[2], y1[3]); *(u32x2*)(rowp + bj * 128) = o8; } }
    }
};

struct Frame {
    LAS unsigned char* lds; int tid, lane, wave, G, vcu, gw, NGW, bx; unsigned char* ws;
};
#define WSP(T_, off) ((T_*)(F.ws + (off)))

__device__ __forceinline__ void transpose_item(const float* W, int ldw, const float* gain, bf16_t* WT, int ldwt, LAS float* scr, int k0, int n0, int lane, bool f8) {
    f32x4 v[16]; const int rr = lane >> 4, cc = 4 * (lane & 15);
#pragma unroll
    for (int i = 0; i < 16; ++i) v[i] = __builtin_nontemporal_load((const f32x4*)(W + (size_t)(k0 + 4 * i + rr) * ldw + n0 + cc));
#pragma unroll
    for (int i = 0; i < 16; ++i) { const int kk = 4 * i + rr; const float gk = gain ? gain[k0 + kk] : 1.f; LAS float* d = scr + kk * 65 + cc;
        d[0] = v[i][0] * gk; d[1] = v[i][1] * gk; d[2] = v[i][2] * gk; d[3] = v[i][3] * gk; }
    LDS_WAIT(); asm volatile("" ::: "memory");
    const int c = lane & 7;
    if (f8) {
#pragma unroll
        for (int p = 0; p < 8; ++p) { const int n = 8 * p + (lane >> 3); const LAS float* s = scr + (8 * c) * 65 + n;
            u32x2 o; o.x = pk4_fp8(s[0 * 65] * W8_SCALE, s[1 * 65] * W8_SCALE, s[2 * 65] * W8_SCALE, s[3 * 65] * W8_SCALE); o.y = pk4_fp8(s[4 * 65] * W8_SCALE, s[5 * 65] * W8_SCALE, s[6 * 65] * W8_SCALE, s[7 * 65] * W8_SCALE);
            *(u32x2*)((unsigned char*)WT + (size_t)(n0 + n) * ldwt + k0 + 8 * c) = o; }
        LDS_WAIT(); asm volatile("" ::: "memory");
        return;
    }
#pragma unroll
    for (int p = 0; p < 8; ++p) { const int n = 8 * p + (lane >> 3); const LAS float* s = scr + (8 * c) * 65 + n;
        u32x4 o; o.x = pk2(s[0 * 65], s[1 * 65]); o.y = pk2(s[2 * 65], s[3 * 65]); o.z = pk2(s[4 * 65], s[5 * 65]); o.w = pk2(s[6 * 65], s[7 * 65]);
        *(u32x4*)(WT + (size_t)(n0 + n) * ldwt + k0 + 8 * c) = o; }
    LDS_WAIT(); asm volatile("" ::: "memory");
}
struct TJob { const float* W; int ldw, K, N; const float* gain; bf16_t* WT; size_t wstride, tstride, gstride; int nmat; bool f8; };
__device__ __forceinline__ bool run_tjob(const TJob& J, int& r, LAS float* scr, int lane) {
    const int nkb = J.K / 64, nnb = J.N / 64, per = nkb * nnb, total = per * J.nmat;
    if (r >= total) { r -= total; return false; }
    const int m = r / per, q = r % per, kb = q / nnb, nb = q % nnb;
    const bool f8 = J.f8;
    transpose_item(J.W + (size_t)m * J.wstride, J.ldw, J.gain ? J.gain + (size_t)(m / 32) * J.gstride : nullptr, f8 ? (bf16_t*)((unsigned char*)J.WT + (size_t)m * J.tstride) : J.WT + (size_t)m * J.tstride, J.K, scr, kb * 64, nb * 64, lane, f8);
    return true;
}

__device__ __forceinline__ void phase_prologue(Frame& F, const Params& P) {
    LAS float* scr = (LAS float*)(F.lds + F.wave * 16640);
    constexpr int NITEMS = 16 * 48 + 256 + 16 * 24 + 256 + 256 + 256 + 256 + 2 * 4 * 16 + 2 * 32 * 4 + 2 * 4 * 1 + 32 * 16 * 32 + 32 * 16 * 16;
#define TJ(...) { const TJob J_ = {__VA_ARGS__}; if (run_tjob(J_, r, scr, F.lane)) continue; }
    for (int it = F.gw; it < NITEMS; it += F.NGW) {
        int r = it;
        TJ(P.fox_w_in, FOXN, 1024, 3072, P.attn_norm, WSP(bf16_t, WS_WFOXIN), 0, 0, 0, 1, false)
        TJ(P.fox_w_out, 1024, 1024, 1024, nullptr, WSP(bf16_t, WS_WFOXOUT), 0, 0, 0, 1, false)
        TJ(P.kv_w, KVN, 1024, KVN, P.kv_norm, WSP(bf16_t, WS_WNSA), 0, 0, 0, 1, false)
        TJ(P.nsa_w_in, NSAN, 1024, 1024, P.attn_norm + D, WSP(bf16_t, WS_WNSA) + (size_t)KVN * 1024, 0, 0, 0, 1, false)
        TJ(P.nsa_w_out, 1024, 1024, 1024, nullptr, WSP(bf16_t, WS_WNSAOUT), 0, 0, 0, 1, false)
        TJ(P.ple_gate_w, 1024, 1024, 1024, P.ple_norm, WSP(bf16_t, WS_WPLEG), 0, 0, 0, 1, true)
        TJ(P.ple_gate_w + (size_t)D * D, 1024, 1024, 1024, P.ple_norm + D, (bf16_t*)(WSP(unsigned char, WS_WPLEG) + (size_t)D * D), 0, 0, 0, 1, true)
        TJ(P.ple_proj_w, 1024, 256, 1024, nullptr, WSP(bf16_t, WS_WPLEP), (size_t)PLE * D, (size_t)PLE * D, 0, 2, false)
        TJ(P.cmp_w1, 256, 2048, 256, nullptr, WSP(bf16_t, WS_WC1), (size_t)2048 * 256, (size_t)2048 * 256, 0, 2, false)
        TJ(P.cmp_w2, 64, 256, 64, nullptr, WSP(bf16_t, WS_WC2), (size_t)256 * 64, (size_t)256 * 64, 0, 2, false)
        TJ(P.w_gu, 2048, 1024, 2048, P.ffn_norm, WSP(bf16_t, WS_WGU), (size_t)1024 * 2048, (size_t)1024 * 2048, (size_t)D, 32, true)
        TJ(P.w_down, 1024, 1024, 1024, nullptr, WSP(bf16_t, WS_WDN), (size_t)1024 * 1024, (size_t)1024 * 1024, 0, 32, true)
    }
#undef TJ
    const int gt = F.vcu * NTHREADS + F.tid, NGT = F.G * NTHREADS;
    float* rope = WSP(float, WS_ROPE);
    for (int i = gt; i < T * 8; i += NGT) { const int t = i >> 3, c = i & 7; const double inv = pow(500000.0, -(double)c / 8.0), ang = (double)t * inv; rope[2 * i] = (float)cos(ang); rope[2 * i + 1] = (float)sin(ang); }
    float* wft = WSP(float, WS_WFT);
    for (int i = gt; i < 32 * 1024; i += NGT) { const int h = i >> 10, k = i & 1023; wft[i] = h < 16 ? P.attn_norm[k] * P.fox_w_in[(size_t)k * FOXN + 3072 + h] : 0.f; }
    float* wrt = WSP(float, WS_WRT);
    for (int i = gt; i < 2 * 32 * 1024; i += NGT) { const int l = i >> 15, e = (i >> 10) & 31, k = i & 1023; wrt[i] = P.ffn_norm[l * D + k] * P.router_w[((size_t)l * D + k) * NE + e]; }
    float* wgt = WSP(float, WS_WGT);
    for (int i = gt; i < 64 * 1024; i += NGT) { const int c = i >> 10, k = i & 1023; wgt[i] = c < 48 ? P.attn_norm[D + k] * P.nsa_w_in[(size_t)k * NSAN + 1024 + c] : 0.f; }
    { const f32x4* src = (const f32x4*)P.p; u32x2* dst = WSP(u32x2, WS_PBF);
      for (int i = gt; i < 2 * M * PLE / 4; i += NGT) { const f32x4 v = src[i]; u32x2 o; o.x = pk2(v[0], v[1]); o.y = pk2(v[2], v[3]); dst[i] = o; } }
    { float* part = WSP(float, WS_H);
      for (int task = F.gw; task < 2 * 4 * 32; task += F.NGW) { const int j = task >> 7, cg = (task >> 5) & 3, mc = task & 31; const int c = cg * 64 + F.lane;
        const float* w = P.cmp_w1 + ((size_t)j * 2048 + mc * 64) * 256 + c; const float* pp = P.cmp_pos + j * 2048 + mc * 64; float s = 0.f;
#pragma unroll 8
        for (int m = 0; m < 64; ++m) s += pp[m] * w[(size_t)m * 256];
        part[(j * 32 + mc) * 256 + c] = s; } }
}

constexpr int L1_ITEMS = 32 * 16 * 32 + 32 * 16 * 16, L1_SPLIT = 4096;
__device__ __forceinline__ void convert_moe_l1(Frame& F, const Params& P, int worker, int nworkers, int it_lo, int it_hi) {
    LAS float* scr = (LAS float*)(F.lds + F.wave * 16640);
    const int w = worker * NWAVES + F.wave, NW = nworkers * NWAVES;
#define TJ(...) { const TJob J_ = {__VA_ARGS__}; if (run_tjob(J_, r, scr, F.lane)) continue; }
    for (int it = it_lo + w; it < it_hi; it += NW) {
        int r = it;
        TJ(P.w_gu + (size_t)32 * 1024 * 2048, 2048, 1024, 2048, P.ffn_norm + D, (bf16_t*)(WSP(unsigned char, WS_WGU) + (size_t)32 * 1024 * 2048), (size_t)1024 * 2048, (size_t)1024 * 2048, 0, 32, true)
        TJ(P.w_down + (size_t)32 * 1024 * 1024, 1024, 1024, 1024, nullptr, (bf16_t*)(WSP(unsigned char, WS_WDN) + (size_t)32 * 1024 * 1024), (size_t)1024 * 1024, (size_t)1024 * 1024, 0, 32, true)
    }
#undef TJ
}

template <class TX>
__device__ __forceinline__ void row_load(const TX* xrow, int lane, f32x4 (&v)[4]) {
#pragma unroll
    for (int j = 0; j < 4; ++j) v[j] = ld4(xrow + 4 * lane + 256 * j);
}
__device__ __forceinline__ float row_rstd(const f32x4 (&v)[4]) {
    float s = 0.f;
#pragma unroll
    for (int j = 0; j < 4; ++j) s += (v[j][0] * v[j][0] + v[j][1] * v[j][1]) + (v[j][2] * v[j][2] + v[j][3] * v[j][3]);
    return __builtin_amdgcn_rsqf(wave_sum(s) * (1.f / D) + EPS);
}
__device__ __forceinline__ void row_store_bf16(bf16_t* orow, int lane, const f32x4 (&v)[4]) {
    u32x2* o8 = (u32x2*)orow + lane;
#pragma unroll
    for (int j = 0; j < 4; ++j) { u32x2 o; o.x = pk2(v[j][0], v[j][1]); o.y = pk2(v[j][2], v[j][3]); o8[64 * j] = o; }
}
__device__ __forceinline__ float row_dot(const f32x4 (&v)[4], const float* w, int lane) {
    const f32x4* wr = (const f32x4*)w + lane; float s = 0.f;
#pragma unroll
    for (int j = 0; j < 4; ++j) { const f32x4 a = wr[64 * j]; s += (v[j][0] * a[0] + v[j][1] * a[1]) + (v[j][2] * a[2] + v[j][3] * a[3]); }
    return s;
}
__device__ __forceinline__ float reduce16(float (&p)[16], int lane) {
#pragma unroll
    for (int i = 0; i < 8; ++i) { const bool up = lane & 32; const float send = up ? p[i] : p[i + 8], keep = up ? p[i + 8] : p[i]; p[i] = keep + __shfl_xor(send, 32); }
#pragma unroll
    for (int i = 0; i < 4; ++i) { const bool up = lane & 16; const float send = up ? p[i] : p[i + 4], keep = up ? p[i + 4] : p[i]; p[i] = keep + __shfl_xor(send, 16); }
#pragma unroll
    for (int i = 0; i < 2; ++i) { const bool up = lane & 8; const float send = up ? p[i] : p[i + 2], keep = up ? p[i + 2] : p[i]; p[i] = keep + __shfl_xor(send, 8); }
    { const bool up = lane & 4; const float send = up ? p[0] : p[1], keep = up ? p[1] : p[0]; p[0] = keep + __shfl_xor(send, 4); }
    p[0] += __shfl_xor(p[0], 2); p[0] += __shfl_xor(p[0], 1);
    return p[0];
}

template <int NT, bool Q8 = false, class TX, class Post>
__device__ __forceinline__ void rowblock_phase(Frame& F, const TX* xsrc, const float* WT, bf16_t* xn, Post post) {
    constexpr int RS = NT * 32 + 1;
    const int lane = F.lane, wid = F.wave, task = wid >> 2, q = wid & 3, i = lane & 31, kh = lane >> 5;
    LAS float* PART = (LAS float*)F.lds;
    LAS float* SSQ = PART + 2 * 4 * 32 * RS;
    LAS float* RSTD = SSQ + 2 * 4 * 2 * 32;
    for (int blk = F.vcu; blk < M / 64; blk += F.G) {
        const int r0 = blk * 64 + task * 32;
        f32x16 acc[NT];
#pragma unroll
        for (int t = 0; t < NT; ++t) acc[t] = splat16z();
        float ssq = 0.f;
        const TX* xr = xsrc + (size_t)(r0 + i) * D + 256 * q + 8 * kh;
        const float* wr = WT + (size_t)i * D + 256 * q + 8 * kh;
#pragma unroll 2
        for (int s = 0; s < 16; ++s) {
            f32x4 a0, a1; ld8(xr + 16 * s, a0, a1);
            ssq += ((a0[0] * a0[0] + a0[1] * a0[1]) + (a0[2] * a0[2] + a0[3] * a0[3])) + ((a1[0] * a1[0] + a1[1] * a1[1]) + (a1[2] * a1[2] + a1[3] * a1[3]));
#pragma unroll
            for (int t = 0; t < NT; ++t) { const f32x4 b0 = *(const f32x4*)(wr + (size_t)t * 32 * D + 16 * s), b1 = *(const f32x4*)(wr + (size_t)t * 32 * D + 16 * s + 4);
#pragma unroll
                for (int q4 = 0; q4 < 4; ++q4) acc[t] = __builtin_amdgcn_mfma_f32_32x32x2f32(a0[q4], b0[q4], acc[t], 0, 0, 0);
#pragma unroll
                for (int q4 = 0; q4 < 4; ++q4) acc[t] = __builtin_amdgcn_mfma_f32_32x32x2f32(a1[q4], b1[q4], acc[t], 0, 0, 0); }
        }
        LAS float* pp = PART + ((task * 4 + q) * 32) * RS;
#pragma unroll
        for (int t = 0; t < NT; ++t)
#pragma unroll
            for (int r = 0; r < 16; ++r) pp[((r & 3) + 8 * (r >> 2) + 4 * kh) * RS + 32 * t + i] = acc[t][r];
        SSQ[((task * 4 + q) * 2 + kh) * 32 + i] = ssq;
        __syncthreads();
        if (q == 0 && lane < 32) {
            float sq = 0.f;
#pragma unroll
            for (int k = 0; k < 8; ++k) sq += SSQ[(task * 8 + k) * 32 + i];
            const float rstd = __builtin_amdgcn_rsqf(sq * (1.f / D) + EPS);
            RSTD[task * 32 + i] = rstd;
            const LAS float* p0 = PART + ((task * 4) * 32 + i) * RS;
            post(r0 + i, rstd, [&](int c) { return (p0[c] + p0[32 * RS + c]) + (p0[64 * RS + c] + p0[96 * RS + c]); });
        }
        __syncthreads();
        if (xn != nullptr)
#pragma unroll 2
        for (int rr = 0; rr < 8; ++rr) {
            const int row = r0 + 8 * q + rr; const float rstd = RSTD[task * 32 + 8 * q + rr];
            f32x4 v[4]; row_load(xsrc + (size_t)row * D, lane, v);
#pragma unroll
            for (int j = 0; j < 4; ++j) v[j] = v[j] * rstd;
            if constexpr (Q8) { unsigned* o4 = (unsigned*)((unsigned char*)xn + (size_t)row * D) + lane;
#pragma unroll
                for (int j = 0; j < 4; ++j) o4[64 * j] = pk4_fp8(v[j][0], v[j][1], v[j][2], v[j][3]); }
            else row_store_bf16(xn + (size_t)row * D, lane, v);
        }
        __syncthreads();
    }
}

__device__ __forceinline__ void phase_fox_pre(Frame& F, const Params& P) {
    if (F.vcu == 0) { const float* part = WSP(float, WS_H); float* cb1 = WSP(float, WS_CB1); const int i = F.tid; const int j = i >> 8, c = i & 255; float s = 0.f;
        for (int mc = 0; mc < 32; ++mc) s += part[(j * 32 + mc) * 256 + c];
        cb1[i] = s; }
    float* logf = WSP(float, WS_LOGF); const float* bf = P.fox_b_f;
    rowblock_phase<1>(F, P.x, WSP(float, WS_WFT), WSP(bf16_t, WS_XN), [&](int row, float rstd, auto get) {
        const size_t base = (size_t)(row >> 13) * NH * T + (row & (T - 1));
#pragma unroll
        for (int h = 0; h < 16; ++h) { const float z = rstd * get(h) + bf[h]; logf[base + (size_t)h * T] = fminf(z, 0.f) - log1pf(__expf(-fabsf(z))); }
    });
}

__device__ __forceinline__ void fox_scan(Frame& F, int bh) {
    const float* lf = WSP(float, WS_LOGF) + (size_t)bh * T; float* bias = WSP(float, WS_BIAS) + (size_t)bh * T; u32x4* kaug = WSP(u32x4, WS_KAUG) + (size_t)bh * T;
    LAS float* sc = (LAS float*)(F.lds);
    float v[16]; float run = 0.f;
    const f32x4* src = (const f32x4*)(lf + F.tid * 16);
#pragma unroll
    for (int i = 0; i < 4; ++i) { const f32x4 a = src[i]; v[4 * i] = a[0]; v[4 * i + 1] = a[1]; v[4 * i + 2] = a[2]; v[4 * i + 3] = a[3]; }
#pragma unroll
    for (int i = 0; i < 16; ++i) { run += v[i]; v[i] = run; }
    const float incl = wave_scan_f(run);
    if (F.lane == 63) sc[F.wave] = incl;
    __syncthreads();
    float woff = 0.f;
    for (int w = 0; w < F.wave; ++w) woff += sc[w];
    const float base = woff + incl - run;
#pragma unroll
    for (int i = 0; i < 16; ++i) {
        const float bv = -(base + v[i]) * LOG2E;
        const unsigned b0 = f2bf(bv); const float r1 = bv - __builtin_bit_cast(float, b0 << 16);
        const unsigned b1 = f2bf(r1); const float r2 = r1 - __builtin_bit_cast(float, b1 << 16);
        const unsigned b2 = f2bf(r2);
        bias[F.tid * 16 + i] = bv;
        u32x4 o; o.x = b0 | (b1 << 16); o.y = b2 | 0x3F800000u; o.z = 0x3F803F80u; o.w = 0u; kaug[F.tid * 16 + i] = o;
    }
    __syncthreads();
}

__device__ __forceinline__ void phase_moe_route(Frame& F, const Params& P, int layer, const bf16_t* xsrc, int cbank = -1) {
    unsigned* cnt = WSP(unsigned, WS_CTL) + CW_CNT + (cbank < 0 ? layer : cbank) * NE * CNT_STRIDE; int* list = WSP(int, WS_LIST); float* gl = WSP(float, WS_GL); int* tokinfo = WSP(int, WS_TOKINFO);
    const float* rb = P.router_b + layer * NE;
    rowblock_phase<1, true>(F, xsrc, WSP(float, WS_WRT) + (size_t)layer * NE * D, WSP(bf16_t, WS_XN8), [&](int row, float rstd, auto get) {
        float v[NE];
#pragma unroll
        for (int e = 0; e < NE; ++e) v[e] = rstd * get(e) + rb[e];
        float tv[4]; int te[4];
#pragma unroll
        for (int k = 0; k < 4; ++k) {
            float best = -INFINITY; int bi = 0;
#pragma unroll
            for (int e = 0; e < NE; ++e) { const bool tk = v[e] > best; best = tk ? v[e] : best; bi = tk ? e : bi; }
            tv[k] = best; te[k] = bi;
#pragma unroll
            for (int e = 0; e < NE; ++e) v[e] = (e == bi) ? -INFINITY : v[e];
        }
        const float e1 = __expf(tv[1] - tv[0]), e2 = __expf(tv[2] - tv[0]), e3 = __expf(tv[3] - tv[0]);
        const float inv = 1.f / (1.f + e1 + e2 + e3);
        const float gk[4] = {inv, e1 * inv, e2 * inv, e3 * inv};
        LAS unsigned* hist = (LAS unsigned*)(F.lds + LDS_MISC + 640) + (F.wave >> 2) * 64;
        const int li = F.lane;
        hist[li] = 0u; LDS_WAIT(); asm volatile("" ::: "memory");
        unsigned rk[4];
#pragma unroll
        for (int k = 0; k < 4; ++k) rk[k] = __hip_atomic_fetch_add(hist + te[k], 1u, __ATOMIC_RELAXED, __HIP_MEMORY_SCOPE_WORKGROUP);
        LDS_WAIT(); asm volatile("" ::: "memory");
        { const unsigned c = hist[li]; unsigned base = 0u; if (c) base = atomicAdd(cnt + li * CNT_STRIDE, c); hist[32 + li] = base; }
        LDS_WAIT(); asm volatile("" ::: "memory");
#pragma unroll
        for (int k = 0; k < 4; ++k) {
            const int e = te[k]; const unsigned pos = hist[32 + e] + rk[k];
            list[(size_t)e * M + pos] = row; gl[(size_t)e * M + pos] = gk[k]; tokinfo[row * 4 + k] = (e << 16) | (int)pos;
        }
    });
}

__device__ __forceinline__ int moe_tables(Frame& F, int layer, LAS int* tstart, LAS int* ecnt) {
    const unsigned* cnt = WSP(unsigned, WS_CTL) + CW_CNT + layer * NE * CNT_STRIDE;
    if (F.tid < NE) ecnt[F.tid] = (int)__hip_atomic_load(cnt + F.tid * CNT_STRIDE, __ATOMIC_RELAXED, __HIP_MEMORY_SCOPE_AGENT);
    __syncthreads();
    if (F.tid == 0) { int s = 0; for (int e = 0; e < NE; ++e) { tstart[e] = s; s += (ecnt[e] + 255) >> 8; } tstart[NE] = s; }
    __syncthreads();
    return __builtin_amdgcn_readfirstlane(tstart[NE]);
}

__device__ __forceinline__ void phase_moe_combine(Frame& F, int layer, const bf16_t* xsrc) {
    LAS int* tstart = (LAS int*)(F.lds + LDS_MISC); LAS int* ecnt = tstart + 64;
    moe_tables(F, layer, tstart, ecnt);
    const int* tokinfo = WSP(int, WS_TOKINFO); const unsigned char* Y = WSP(unsigned char, WS_Y); bf16_t* xb = WSP(bf16_t, WS_XB);
    for (int row = F.gw; row < M; row += F.NGW) {
        f32x4 v[4]; row_load(xsrc + (size_t)row * D, F.lane, v);
#pragma unroll
        for (int k = 0; k < 4; ++k) {
            const int ti = tokinfo[row * 4 + k]; const int e = ti >> 16, pos = ti & 0xffff; const size_t slot = (size_t)tstart[e] * 256 + pos;
            const unsigned* yr = (const unsigned*)(Y + slot * D) + F.lane;
#pragma unroll
            for (int j = 0; j < 4; ++j) { const int w = (int)yr[64 * j]; const f32x2 lo = __builtin_amdgcn_cvt_pk_f32_fp8(w, false), hi2 = __builtin_amdgcn_cvt_pk_f32_fp8(w, true);
                v[j][0] += lo[0] * Y8_INV; v[j][1] += lo[1] * Y8_INV; v[j][2] += hi2[0] * Y8_INV; v[j][3] += hi2[1] * Y8_INV; }
        }
#pragma unroll
        for (int j = 0; j < 4; ++j) st4(xb + (size_t)row * D + 4 * F.lane + 256 * j, v[j]);
        const float rs = row_rstd(v);
#pragma unroll
        for (int j = 0; j < 4; ++j) v[j] = v[j] * rs;
        { unsigned* o4 = (unsigned*)(WSP(unsigned char, WS_XN8) + (size_t)row * D) + F.lane;
#pragma unroll
          for (int j = 0; j < 4; ++j) o4[64 * j] = pk4_fp8(v[j][0], v[j][1], v[j][2], v[j][3]); }
    }
}

__device__ __forceinline__ void phase_nsa_pre(Frame& F) {
    float* gates = WSP(float, WS_GATES);
    float* rstd_out = WSP(float, WS_RSTD);
    rowblock_phase<2>(F, WSP(bf16_t, WS_XB), WSP(float, WS_WGT), (bf16_t*)nullptr, [&](int row, float rstd, auto get) {
        rstd_out[row] = rstd;
#pragma unroll
        for (int c4 = 0; c4 < 12; ++c4) { f32x4 o;
#pragma unroll
            for (int jj = 0; jj < 4; ++jj) o[jj] = 1.f / (1.f + __expf(-rstd * get(4 * c4 + jj)));
            *(f32x4*)(gates + (size_t)row * 48 + 4 * c4) = o; }
    });
}

constexpr int AT_K0 = 0  , AT_V0 = 16384  , AT_OST = 0  , AT_WSF = 40960, AT_IMP = 43008, AT_SELM = 75776, AT_OT = 76800, AT_END = AT_OT + 65536;
static_assert(AT_END <= LDS_MISC, "attention LDS map vs control words");
static_assert(AT_END <= LDS_BYTES, "attention LDS map");
__device__ __forceinline__ int crow(int r, int hi) { return (r & 3) + 8 * (r >> 2) + 4 * hi; }
__device__ __forceinline__ unsigned cvtpk(float lo, float hi) { f32x2 v = {lo, hi}; bf16x2_t b = __builtin_convertvector(v, bf16x2_t); return __builtin_bit_cast(unsigned, b); }
typedef short v4i16_t __attribute__((ext_vector_type(4)));
__device__ __forceinline__ s16x4 vtr(const LAS char* p) { return __builtin_bit_cast(s16x4, __builtin_amdgcn_ds_read_tr16_b64_v4i16((LAS v4i16_t*)p)); }

__device__ __forceinline__ void glds16(const void* gsrc, unsigned lds_dst) { unsigned keep;
    asm volatile("s_mov_b32 %0, m0\n\ts_mov_b32 m0, %2\n\ts_nop 0\n\tglobal_load_lds_dwordx4 %1, off\n\ts_mov_b32 m0, %0" : "=&s"(keep) : "v"(gsrc), "s"(lds_dst) : "memory"); }
#define WAIT_BAR0() asm volatile("s_waitcnt vmcnt(0) lgkmcnt(0)\n\ts_barrier" ::: "memory")
__device__ __forceinline__ void tile_dma(const bf16_t* Kt, const bf16_t* Vt, LAS unsigned char* lds, int buf, int tid, int wave) {
    const unsigned base = (unsigned)(uintptr_t)lds + (unsigned)wave * 1024u + (unsigned)buf * 8192u;
    glds16(Kt + tid * 8, (unsigned)__builtin_amdgcn_readfirstlane((int)(base + AT_K0)));
    glds16(Vt + tid * 8, (unsigned)__builtin_amdgcn_readfirstlane((int)(base + AT_V0)));
}
struct TileRegs { u32x4 k, v; };
__device__ __forceinline__ void tile_load(TileRegs& r, const bf16_t* Kt, const bf16_t* Vt, int stride, int tid) {
    (void)stride;
    r.k = *(const u32x4*)(Kt + tid * 8);
    r.v = *(const u32x4*)(Vt + tid * 8);
}
__device__ __forceinline__ void tile_store(const TileRegs& r, LAS unsigned char* lds, int buf, int tid) {
    *(LAS u32x4*)(lds + AT_K0 + buf * 8192 + tid * 16) = r.k;
    *(LAS u32x4*)(lds + AT_V0 + buf * 8192 + tid * 16) = r.v;
}
__device__ __forceinline__ void qk_tile(f32x16& p0, f32x16& p1, const LAS unsigned char* Kbuf, const bf16x8 (&qr)[4], int r32, int hi) {
    const f32x16 cinit = {0.f, 0.f, 0.f, 0.f, 0.f, 0.f, 0.f, 0.f, 0.f, 0.f, 0.f, 0.f, 0.f, 0.f, 0.f, 0.f};
    const LAS unsigned char* kb = Kbuf + hi * 1024 + r32 * 16;
    bf16x8 kf[8];
#pragma unroll
    for (int d0 = 0; d0 < 4; ++d0) { kf[d0] = *(const LAS bf16x8*)(kb + d0 * 2048); kf[4 + d0] = *(const LAS bf16x8*)(kb + d0 * 2048 + 512); }
    __builtin_amdgcn_sched_barrier(0);
#pragma unroll
    for (int d0 = 0; d0 < 4; ++d0) p0 = __builtin_amdgcn_mfma_f32_32x32x16_bf16(kf[d0], qr[d0], d0 ? p0 : cinit, 0, 0, 0);
#pragma unroll
    for (int d0 = 0; d0 < 4; ++d0) p1 = __builtin_amdgcn_mfma_f32_32x32x16_bf16(kf[4 + d0], qr[d0], d0 ? p1 : cinit, 0, 0, 0);
}
struct VFrag { s16x4 lo[2][4], hh[2][4]; };
__device__ __forceinline__ void v_load(VFrag& vf, const LAS unsigned char* Vbuf, int lane) {
    const int hi = lane >> 5;
    const LAS char* vp = (const LAS char*)Vbuf + ((lane >> 4) & 1) * 32 + (lane & 3) * 8 + (4 * hi + ((lane & 15) >> 2)) * 64;
#pragma unroll
    for (int d0 = 0; d0 < 2; ++d0)
#pragma unroll
        for (int ks = 0; ks < 4; ++ks) { vf.lo[d0][ks] = vtr(vp + d0 * 4096 + ks * 1024); vf.hh[d0][ks] = vtr(vp + d0 * 4096 + ks * 1024 + 512); }
    __builtin_amdgcn_sched_barrier(0);
}
__device__ __forceinline__ void pv_tile(f32x16 (&o)[2], const VFrag& vf, const f32x16& p0, const f32x16& p1) {
    u32x4 pw[4];
#pragma unroll
    for (int i = 0; i < 4; ++i) { pw[0][i] = cvtpk(p0[2 * i], p0[2 * i + 1]); pw[1][i] = cvtpk(p0[8 + 2 * i], p0[9 + 2 * i]); pw[2][i] = cvtpk(p1[2 * i], p1[2 * i + 1]); pw[3][i] = cvtpk(p1[8 + 2 * i], p1[9 + 2 * i]); }
#pragma unroll
    for (int d0 = 0; d0 < 2; ++d0)
#pragma unroll
        for (int ks = 0; ks < 4; ++ks) {
            const bf16x8 v8 = (bf16x8){vf.lo[d0][ks][0], vf.lo[d0][ks][1], vf.lo[d0][ks][2], vf.lo[d0][ks][3], vf.hh[d0][ks][0], vf.hh[d0][ks][1], vf.hh[d0][ks][2], vf.hh[d0][ks][3]};
            o[d0] = __builtin_amdgcn_mfma_f32_32x32x16_bf16(__builtin_bit_cast(bf16x8, pw[ks]), v8, o[d0], 0, 0, 0);
        }
}
__device__ __forceinline__ float half_swap_add(float v) { return xor32_sum(v); }
__device__ __forceinline__ f32x16 splat16(float v) { f32x16 r;
#pragma unroll
    for (int i = 0; i < 16; ++i) r[i] = v; return r; }
__device__ __forceinline__ float psum(const f32x16& p0, const f32x16& p1) { float s = 0.f;
#pragma unroll
    for (int r = 0; r < 16; ++r) s += p0[r] + p1[r]; return s; }

template <class RowPtr>
__device__ __forceinline__ void store_o(const f32x16 (&o)[2], LAS unsigned char* lds, int wid, int lane, RowPtr rowptr) {
    const int r32 = lane & 31, hi = lane >> 5;
    LAS bf16_t* stg = (LAS bf16_t*)(lds + AT_OST) + wid * 2048;
#pragma unroll
    for (int r = 0; r < 16; ++r) { const int orow = crow(r, hi);
#pragma unroll
        for (int d0 = 0; d0 < 2; ++d0) stg[orow * 64 + d0 * 32 + r32] = (bf16_t)f2bf(o[d0][r]); }
    LDS_WAIT();
#pragma unroll
    for (int i = 0; i < 4; ++i) { const int row = i * 8 + (lane >> 3), ch = lane & 7; const u32x4 v = *(const LAS u32x4*)(stg + row * 64 + ch * 8); *(u32x4*)(rowptr(row) + ch * 8) = v; }
    LDS_WAIT();
}
__device__ __forceinline__ void row_factors(float f, float (&fr)[16], LAS unsigned char* lds, int wid, int lane) {
    LAS float* wsf = (LAS float*)(lds + AT_WSF) + wid * 64; const int r32 = lane & 31, hi = lane >> 5;
    if (hi == 0) wsf[r32] = f;
    LDS_WAIT();
#pragma unroll
    for (int r = 0; r < 16; ++r) fr[r] = wsf[crow(r, hi)];
    LDS_WAIT();
}
__device__ __forceinline__ float gain_bound(const float* ga, const float* gb, int lane) {
    const float a = wave_max(fabsf(ga[lane])), b = wave_max(fabsf(gb[lane]));
    return 8.f * a * b * LOG2E * 1.03f + 0.05f;
}

__device__ __forceinline__ void fox_unit(Frame& F, const Params& P, int b, int h, int qb, float qbound) {
    const int tid = F.tid, lane = F.lane, wid = F.wave, r32 = lane & 31, hi = lane >> 5;
    const bf16_t* Q = WSP(bf16_t, WS_Q); const bf16_t* Kb = WSP(bf16_t, WS_K); const bf16_t* Vb = WSP(bf16_t, WS_V); bf16_t* O = WSP(bf16_t, WS_O);
    const float* bias = WSP(float, WS_BIAS) + (size_t)(b * NH + h) * T; const u32x4* kaug = WSP(u32x4, WS_KAUG) + (size_t)(b * NH + h) * T;
    const size_t rowbase = (size_t)b * T; const int q0 = qb * 256; const int t = q0 + wid * 32 + r32;
    bf16x8 qr[4];
#pragma unroll
    for (int d0 = 0; d0 < 4; ++d0) qr[d0] = *(const bf16x8*)(Q + (rowbase + t) * D + h * 64 + d0 * 16 + hi * 8);
    bf16x8 qa = (bf16x8){0, 0, 0, 0, 0, 0, 0, 0};
    if (hi == 0) { const float cv = -(bias[t] + qbound); const unsigned c0 = f2bf(cv); const float r1 = cv - __builtin_bit_cast(float, c0 << 16); const unsigned c1 = f2bf(r1); const float r2 = r1 - __builtin_bit_cast(float, c1 << 16); const unsigned c2 = f2bf(r2);
        qa = (bf16x8){0x3F80, 0x3F80, 0x3F80, (short)c0, (short)c1, (short)c2, 0, 0}; }
    f32x16 o[2]; o[0] = splat16(0.f); o[1] = splat16(0.f); float l = 0.f;
    const int NT = 4 * qb + 4;
    int jmin;
    { const float thr = 2.f * qbound + 44.f, bq = bias[q0];
      const bool c0 = (lane < NT) && (bq - bias[64 * lane + 63] <= thr), c1 = (lane + 64 < NT) && (bq - bias[64 * (lane + 64) + 63] <= thr);
      const unsigned long long m0 = __ballot(c0), m1 = __ballot(c1);
      jmin = m0 ? (__ffsll((long long)m0) - 1) : (64 + __ffsll((long long)m1) - 1); }
    const int ntile = NT - jmin;
    int jmin_w;
    { const float thr = 2.f * qbound + 44.f, bq = bias[q0 + wid * 32];
      const bool c0 = (lane < NT) && (bq - bias[64 * lane + 63] <= thr), c1 = (lane + 64 < NT) && (bq - bias[64 * (lane + 64) + 63] <= thr);
      const unsigned long long m0 = __ballot(c0), m1 = __ballot(c1);
      jmin_w = m0 ? (__ffsll((long long)m0) - 1) : (m1 ? (64 + __ffsll((long long)m1) - 1) : NT); }
    const bf16_t* Kh = Kb + ((size_t)(b * NH + h) * T) * HD; const bf16_t* Vh = Vb + ((size_t)(b * NH + h) * T) * HD;
    tile_dma(Kh + (size_t)(NT - 1) * 4096, Vh + (size_t)(NT - 1) * 4096, F.lds, 0, tid, wid);
    u32x4 kan0 = kaug[(NT - 1) * 64 + r32], kan1 = kaug[(NT - 1) * 64 + 32 + r32];
    WAIT_BAR0();
    for (int jj = 0; jj < ntile; ++jj) {
        const int j = NT - 1 - jj;
        const u32x4 ka0 = kan0, ka1 = kan1;
        if (jj + 1 < ntile) { tile_dma(Kh + (size_t)(j - 1) * 4096, Vh + (size_t)(j - 1) * 4096, F.lds, (jj + 1) & 1, tid, wid); kan0 = kaug[(j - 1) * 64 + r32]; kan1 = kaug[(j - 1) * 64 + 32 + r32]; }
        const LAS unsigned char* Kbuf = F.lds + AT_K0 + (jj & 1) * 8192; const LAS unsigned char* Vbuf = F.lds + AT_V0 + (jj & 1) * 8192;
        if (j * 64 <= q0 + wid * 32 + 31 && j >= jmin_w) {
        f32x16 p0, p1; qk_tile(p0, p1, Kbuf, qr, r32, hi);
        p0 = __builtin_amdgcn_mfma_f32_32x32x16_bf16(__builtin_bit_cast(bf16x8, ka0), qa, p0, 0, 0, 0);
        p1 = __builtin_amdgcn_mfma_f32_32x32x16_bf16(__builtin_bit_cast(bf16x8, ka1), qa, p1, 0, 0, 0);
        VFrag vf; v_load(vf, Vbuf, lane);
        const bool band = j >= 4 * qb;
        if (band) {
#pragma unroll
            for (int r = 0; r < 16; ++r) {
                const int kv = j * 64 + crow(r, hi);
                const float e0 = __builtin_amdgcn_exp2f(p0[r]), e1 = __builtin_amdgcn_exp2f(p1[r]);
                p0[r] = kv > t ? 0.f : e0; p1[r] = kv + 32 > t ? 0.f : e1;
            }
        } else {
#pragma unroll
            for (int r = 0; r < 16; ++r) { p0[r] = __builtin_amdgcn_exp2f(p0[r]); p1[r] = __builtin_amdgcn_exp2f(p1[r]); }
        }
        l += psum(p0, p1);
        pv_tile(o, vf, p0, p1);
        }
        WAIT_BAR0();
    }
    l = half_swap_add(l);
    float fr[16]; row_factors(1.f / l, fr, F.lds, wid, lane);
#pragma unroll
    for (int r = 0; r < 16; ++r) { o[0][r] *= fr[r]; o[1][r] *= fr[r]; }
    bf16_t* Ow = O + (rowbase + q0 + wid * 32) * D + h * 64;
    store_o(o, F.lds, wid, lane, [&](int row) { return Ow + (size_t)row * D; });
    __syncthreads();
}
__device__ __forceinline__ void phase_fox_attn(Frame& F, const Params& P) {
    const float qbound = gain_bound(P.fox_qk_gain, P.fox_qk_gain + 64, F.lane);
    const int NU = NB * NH * 32;
    for (int i = 0; ; ++i) {
        int bh, qb;
        { const int u = i * F.G + F.vcu; if (u >= NU) break; bh = u >> 5; qb = (u + 8 * i) & 31; }
        fox_unit(F, P, bh >> 4, bh & 15, qb, qbound);
    }
}

template <class KP, class VP, class Body>
__device__ __forceinline__ void tile_loop(Frame& F, int nt, KP kptr, VP vptr, int stride, Body body) {
    const int tid = F.tid; (void)stride;
    tile_dma(kptr(0), vptr(0), F.lds, 0, tid, F.wave); WAIT_BAR0();
    for (int j = 0; j < nt; ++j) {
        if (j + 1 < nt) tile_dma(kptr(j + 1), vptr(j + 1), F.lds, (j + 1) & 1, tid, F.wave);
        body(j, (const LAS unsigned char*)(F.lds + AT_K0 + (j & 1) * 8192), (const LAS unsigned char*)(F.lds + AT_V0 + (j & 1) * 8192));
        WAIT_BAR0();
    }
}


template <class Fin>
__device__ __forceinline__ void attn_tile(f32x16 (&o)[2], float& l, const LAS unsigned char* Kbuf, const LAS unsigned char* Vbuf, const bf16x8 (&qr)[4], int lane, Fin fin) {
    const int r32 = lane & 31, hi = lane >> 5;
    const f32x16 z = {0.f, 0.f, 0.f, 0.f, 0.f, 0.f, 0.f, 0.f, 0.f, 0.f, 0.f, 0.f, 0.f, 0.f, 0.f, 0.f};
    const LAS unsigned char* kb = Kbuf + hi * 1024 + r32 * 16;
    const LAS char* vp = (const LAS char*)Vbuf + ((lane >> 4) & 1) * 32 + (lane & 3) * 8 + (4 * hi + ((lane & 15) >> 2)) * 64;
    bf16x8 kf[8];
#pragma unroll
    for (int d0 = 0; d0 < 4; ++d0) { kf[d0] = *(const LAS bf16x8*)(kb + d0 * 2048); kf[4 + d0] = *(const LAS bf16x8*)(kb + d0 * 2048 + 512); }
    __builtin_amdgcn_sched_barrier(0);
    f32x16 p0, p1;
#pragma unroll
    for (int d0 = 0; d0 < 4; ++d0) p0 = __builtin_amdgcn_mfma_f32_32x32x16_bf16(kf[d0], qr[d0], d0 ? p0 : z, 0, 0, 0);
#pragma unroll
    for (int d0 = 0; d0 < 4; ++d0) p1 = __builtin_amdgcn_mfma_f32_32x32x16_bf16(kf[4 + d0], qr[d0], d0 ? p1 : z, 0, 0, 0);
    s16x4 vlo[2][4], vhh[2][4];
#pragma unroll
    for (int d0 = 0; d0 < 2; ++d0)
#pragma unroll
        for (int ks = 0; ks < 4; ++ks) { vlo[d0][ks] = vtr(vp + d0 * 4096 + ks * 1024); vhh[d0][ks] = vtr(vp + d0 * 4096 + ks * 1024 + 512); }
    __builtin_amdgcn_sched_barrier(0);
#define AT_FIN(P, KOFF, PA, PB) \
        fin(P, KOFF); \
        { float s_ = 0.f; _Pragma("unroll") for (int r = 0; r < 16; ++r) s_ += P[r]; l += s_; } \
        u32x4 PA, PB; _Pragma("unroll") for (int i = 0; i < 4; ++i) { PA[i] = cvtpk(P[2 * i], P[2 * i + 1]); PB[i] = cvtpk(P[8 + 2 * i], P[9 + 2 * i]); }
#define AT_PV(PA, PB, KS0) \
        _Pragma("unroll") for (int d0 = 0; d0 < 2; ++d0) { \
            o[d0] = __builtin_amdgcn_mfma_f32_32x32x16_bf16(__builtin_bit_cast(bf16x8, PA), (bf16x8){vlo[d0][KS0][0], vlo[d0][KS0][1], vlo[d0][KS0][2], vlo[d0][KS0][3], vhh[d0][KS0][0], vhh[d0][KS0][1], vhh[d0][KS0][2], vhh[d0][KS0][3]}, o[d0], 0, 0, 0); \
            o[d0] = __builtin_amdgcn_mfma_f32_32x32x16_bf16(__builtin_bit_cast(bf16x8, PB), (bf16x8){vlo[d0][KS0 + 1][0], vlo[d0][KS0 + 1][1], vlo[d0][KS0 + 1][2], vlo[d0][KS0 + 1][3], vhh[d0][KS0 + 1][0], vhh[d0][KS0 + 1][1], vhh[d0][KS0 + 1][2], vhh[d0][KS0 + 1][3]}, o[d0], 0, 0, 0); }
    AT_FIN(p0, 0, pa0, pb0)
    __builtin_amdgcn_sched_barrier(0);
    AT_PV(pa0, pb0, 0)
    AT_FIN(p1, 32, pa1, pb1)
    __builtin_amdgcn_sched_barrier(0);
    AT_PV(pa1, pb1, 2)
#undef AT_FIN
#undef AT_PV
}

__device__ __forceinline__ void nsa_unit(Frame& F, int b, int g, int tb, float qb_c, float qb_s, float qb_w) {
    const int tid = F.tid, lane = F.lane, wid = F.wave, r32 = lane & 31, hi = lane >> 5;
    const int q0 = tb * 64, cur = tb, bg = b * NG + g;
    const int hh = r32 >> 3, tk = 8 * wid + (r32 & 7), t = q0 + tk, head = 4 * g + hh; const size_t row = (size_t)b * T + t;
    const bf16_t* Q = WSP(bf16_t, WS_Q); bf16_t* O = WSP(bf16_t, WS_O); const float* gates = WSP(float, WS_GATES) + row * 48 + head;
    const bf16_t* KC = WSP(bf16_t, WS_KC) + (size_t)bg * 512 * 64; const bf16_t* VC = WSP(bf16_t, WS_VC) + (size_t)bg * 512 * 64;
    const bf16_t* KS = WSP(bf16_t, WS_KS) + (size_t)bg * T * 64; const bf16_t* VS = WSP(bf16_t, WS_VS) + (size_t)bg * T * 64;
    const bf16_t* KW = WSP(bf16_t, WS_KW) + (size_t)bg * T * 64; const bf16_t* VW = WSP(bf16_t, WS_VW) + (size_t)bg * T * 64;
    LAS float* IMP = (LAS float*)(F.lds + AT_IMP); LAS unsigned* SELM = (LAS unsigned*)(F.lds + AT_SELM);
    bf16x8 qr[4];
#pragma unroll
    for (int d0 = 0; d0 < 4; ++d0) qr[d0] = *(const bf16x8*)(Q + row * D + head * 64 + d0 * 16 + hi * 8);
    const float g_c = gates[0], g_s = gates[16], g_w = gates[32];
    LAS float* OT = (LAS float*)(F.lds + AT_OT) + wid * 2048 + lane;
    float fr[16];

    const int NTc = (((q0 + 32) >> 4) >> 6) + 1; const int nmax = (t - 31) >> 4;
    const float sh_c = exp2f(-fmaxf(qb_c - 20.f, 0.f)), sh_s = exp2f(-fmaxf(qb_s - 20.f, 0.f)), sh_w = exp2f(-fmaxf(qb_w - 20.f, 0.f));
    float l_c = 0.f;
    const int nvis_all = (q0 - 31) >> 4, nvis_any = (q0 + 32) >> 4;
    auto fin_half = [&](f32x16& p, int nbase, float mul) {
        if (nbase + 31 <= nvis_all) {
#pragma unroll
            for (int r = 0; r < 16; ++r) p[r] = __builtin_amdgcn_exp2f(p[r]) * mul;
        } else if (nbase > nvis_any) {
#pragma unroll
            for (int r = 0; r < 16; ++r) p[r] = 0.f;
        } else {
#pragma unroll
            for (int r = 0; r < 16; ++r) p[r] = (nbase + crow(r, hi) <= nmax) ? __builtin_amdgcn_exp2f(p[r]) * mul : 0.f;
        }
    };
    tile_loop(F, NTc, [&](int j) { return KC + (size_t)j * 4096; }, [&](int j) { return VC + (size_t)j * 4096; }, 64, [&](int j, const LAS unsigned char* Kbuf, const LAS unsigned char* Vbuf) {
        f32x16 p0, p1; qk_tile(p0, p1, Kbuf, qr, r32, hi);
        fin_half(p0, j * 64, sh_c); fin_half(p1, j * 64 + 32, sh_c);
        l_c += psum(p0, p1);
    });
    l_c = half_swap_add(l_c);
    const float rl = l_c > 0.f ? sh_c / l_c : 0.f;
    {
        f32x16 o[2]; o[0] = splat16(0.f); o[1] = splat16(0.f); float carry = 0.f;
        tile_loop(F, NTc, [&](int j) { return KC + (size_t)j * 4096; }, [&](int j) { return VC + (size_t)j * 4096; }, 64, [&](int j, const LAS unsigned char* Kbuf, const LAS unsigned char* Vbuf) {
            f32x16 p0, p1; qk_tile(p0, p1, Kbuf, qr, r32, hi);
            VFrag vf; v_load(vf, Vbuf, lane);
            fin_half(p0, j * 64, rl); fin_half(p1, j * 64 + 32, rl);
            float rx03 = 0.f, rx13 = 0.f;
#pragma unroll
            for (int c = 0; c < 2; ++c) {
                float A[4], rX[4];
#pragma unroll
                for (int gq = 0; gq < 4; ++gq) {
                    const float x = 16.f * (c ? p1[4 * gq + 3] : p0[4 * gq + 3]);
                    A[gq] = 32.f * (c ? (p1[4 * gq] + p1[4 * gq + 1] + p1[4 * gq + 2]) : (p0[4 * gq] + p0[4 * gq + 1] + p0[4 * gq + 2])) + x;
                    rX[gq] = xor32_other(x);
                }
#pragma unroll
                for (int gq = 0; gq < 4; ++gq) {
                    const float prev = gq > 0 ? rX[gq - 1] : (c > 0 ? rx03 : carry);
                    float tot = A[gq] + (hi ? rX[gq] : prev);
                    tot = xor16_sum(xor8_sum(tot));
                    if (r32 < 8) IMP[tk * 128 + 16 * j + 8 * c + 2 * gq + hi] = tot;
                }
                if (c == 0) rx03 = rX[3]; else rx13 = rX[3];
            }
            carry = rx13;
            pv_tile(o, vf, p0, p1);
        });
        row_factors(g_c, fr, F.lds, wid, lane);
#pragma unroll
        for (int r = 0; r < 16; ++r) { OT[r * 64] = o[0][r] * fr[r]; OT[(16 + r) * 64] = o[1][r] * fr[r]; }
    }
    unsigned m0 = 0u, m1 = 0u, m2 = 0u, m3 = 0u;
    {
        LDS_WAIT(); asm volatile("" ::: "memory");
        const int tkk = lane >> 3, sub = lane & 7;
#define SETBIT(jx) do { const int j_ = (jx); const unsigned bit_ = 1u << (j_ & 31); const int w_ = j_ >> 5; m0 |= (w_ == 0) ? bit_ : 0u; m1 |= (w_ == 1) ? bit_ : 0u; m2 |= (w_ == 2) ? bit_ : 0u; m3 |= (w_ == 3) ? bit_ : 0u; } while (0)
        if (cur <= 15) { m0 = (cur == 31) ? 0xffffffffu : ((1u << (cur + 1)) - 1u); }
        else {
            SETBIT(0); SETBIT(cur); SETBIT(cur - 1);
            unsigned key[16];
#pragma unroll
            for (int i = 0; i < 16; ++i) { const int jx = sub + 8 * i; const unsigned kb_ = (__float_as_uint(IMP[(8 * wid + tkk) * 128 + jx]) & ~0x7Fu) | (unsigned)(127 - jx); key[i] = (jx >= 1 && jx <= cur - 2) ? kb_ : 0u; }
#pragma unroll 1
            for (int rnd = 0; rnd < SELTOP - 3; ++rnd) {
                unsigned best = 0u;
#pragma unroll
                for (int i = 0; i < 16; ++i) best = max(best, key[i]);
                best = max8_u32(best);
                const int bj = 127 - (int)(best & 0x7Fu);
                SETBIT(bj);
#pragma unroll
                for (int i = 0; i < 16; ++i) key[i] = (key[i] == best) ? 0u : key[i];
            }
        }
#undef SETBIT
        if (sub == 0) { LAS unsigned* d = SELM + (8 * wid + tkk) * 4; d[0] = m0; d[1] = m1; d[2] = m2; d[3] = m3; }
        LDS_WAIT(); asm volatile("" ::: "memory");
        const LAS unsigned* s = SELM + tk * 4; m0 = s[0]; m1 = s[1]; m2 = s[2]; m3 = s[3];
        LDS_WAIT();
    }
    {
        f32x16 o[2]; o[0] = splat16(0.f); o[1] = splat16(0.f); float l = 0.f;
        tile_loop(F, cur + 1, [&](int j) { return KS + (size_t)j * 4096; }, [&](int j) { return VS + (size_t)j * 4096; }, 64, [&](int j, const LAS unsigned char* Kbuf, const LAS unsigned char* Vbuf) {
            const unsigned w = j < 32 ? m0 : j < 64 ? m1 : j < 96 ? m2 : m3; const bool sel = (w >> (j & 31)) & 1u;
            if (__any(sel)) {
                const float sc = sel ? sh_s : 0.f; const bool diag = j == cur;
                attn_tile(o, l, Kbuf, Vbuf, qr, lane, [&](f32x16& p, int koff) {
#pragma unroll
                    for (int r = 0; r < 16; ++r) { float e = __builtin_amdgcn_exp2f(p[r]) * sc; if (diag) e = crow(r, hi) + koff > tk ? 0.f : e; p[r] = e; } });
            }
        });
        l = half_swap_add(l);
        row_factors(g_s / l, fr, F.lds, wid, lane);
#pragma unroll
        for (int r = 0; r < 16; ++r) { OT[r * 64] += o[0][r] * fr[r]; OT[(16 + r) * 64] += o[1][r] * fr[r]; }
    }
    {
        f32x16 o[2]; o[0] = splat16(0.f); o[1] = splat16(0.f); float l = 0.f;
        const int j0 = cur >= 8 ? cur - 8 : 0;
        tile_loop(F, cur - j0 + 1, [&](int j) { return KW + (size_t)(j0 + j) * 4096; }, [&](int j) { return VW + (size_t)(j0 + j) * 4096; }, 64, [&](int j, const LAS unsigned char* Kbuf, const LAS unsigned char* Vbuf) {
            const bool first = (j0 + j) == cur - 8, diag = (j0 + j) == cur;
            if (first) attn_tile(o, l, Kbuf, Vbuf, qr, lane, [&](f32x16& p, int koff) {
#pragma unroll
                for (int r = 0; r < 16; ++r) { const int kk = crow(r, hi) + koff; const float e = __builtin_amdgcn_exp2f(p[r]) * sh_w; p[r] = kk <= tk ? 0.f : e; } });
            else if (diag) attn_tile(o, l, Kbuf, Vbuf, qr, lane, [&](f32x16& p, int koff) {
#pragma unroll
                for (int r = 0; r < 16; ++r) { const int kk = crow(r, hi) + koff; const float e = __builtin_amdgcn_exp2f(p[r]) * sh_w; p[r] = kk > tk ? 0.f : e; } });
            else attn_tile(o, l, Kbuf, Vbuf, qr, lane, [&](f32x16& p, int koff) {
#pragma unroll
                for (int r = 0; r < 16; ++r) p[r] = __builtin_amdgcn_exp2f(p[r]) * sh_w; });
        });
        l = half_swap_add(l);
        row_factors(g_w / l, fr, F.lds, wid, lane);
#pragma unroll
        for (int r = 0; r < 16; ++r) { o[0][r] = OT[r * 64] + o[0][r] * fr[r]; o[1][r] = OT[(16 + r) * 64] + o[1][r] * fr[r]; }
        LDS_WAIT();
        bf16_t* Ob_ = O + ((size_t)b * T + q0 + 8 * wid) * D + 4 * g * 64;
        store_o(o, F.lds, wid, lane, [&](int r) { return Ob_ + (size_t)(r & 7) * D + (r >> 3) * 64; });
    }
    __syncthreads();
}
__device__ __forceinline__ void phase_nsa_attn(Frame& F, const Params& P) {
    const float qb_c = gain_bound(P.nsa_q_gain, P.kv_k_gain, F.lane), qb_s = gain_bound(P.nsa_q_gain, P.kv_k_gain + 64, F.lane), qb_w = gain_bound(P.nsa_q_gain, P.kv_k_gain + 128, F.lane);
    const int NU = NB * NG * 128;
    for (int i = 0; ; ++i) {
        int bg, tb;
        if (F.G == 256) { if (i >= 4) break; const int s = F.vcu & 31; bg = F.vcu >> 5; tb = (i == 0) ? s : (i == 1) ? 63 - s : (i == 2) ? 64 + s : 127 - s; }
        else { const int u = i * F.G + F.vcu; if (u >= NU) break; bg = u >> 7; tb = 127 - (u & 127); }
        nsa_unit(F, bg >> 2, bg & 3, tb, qb_c, qb_s, qb_w);
    }
}

struct CmpSched : BrowStd {
    const char* A; const char* Bt; int G, c;
    __device__ __forceinline__ bool next(int i, gm::Unit& u) const { if (i > 0 || c >= 32) return false; u.aux = c >> 4; u.pm = c & 15; u.pn = 0; u.cnt = 0; return true; }
    __device__ __forceinline__ const char* a_base() const { return A; }
    __device__ __forceinline__ unsigned a_off(const gm::Unit& u, int row) const { return (unsigned)u.aux * (unsigned)KV6_STRIDE + (unsigned)(u.pm * 256 + row) * 2048u; }
    __device__ __forceinline__ const char* b_base(const gm::Unit& u) const { return Bt + (size_t)u.aux * (256 * 2048 * 2); }
    __device__ __forceinline__ size_t hstepB() const { return (size_t)128 * 2048 * 2; }
};
struct EpiCompress {
    static constexpr bool AFTER_DRAIN = true;
    const float* cb1; const bf16_t* w2t; const float* kgain; const float* rope; bf16_t* KC; bf16_t* VC;
    __device__ __forceinline__ void operator()(const f32x4 (&)[2][2][4][2], const gm::Unit&, int, int, int, int) const {}
    __device__ __forceinline__ void fused(f32x4 (&acc)[2][2][4][2], const gm::Unit& u, int wr, int wc, int fr, int fq, LAS unsigned char* lds, int wid, int lane) const {
        const int j = u.aux;
#pragma unroll
        for (int bj = 0; bj < 2; ++bj) {
            const int col0 = 128 * bj + 32 * wc + 8 * fq; const f32x4 b0 = *(const f32x4*)(cb1 + j * 256 + col0), b1 = *(const f32x4*)(cb1 + j * 256 + col0 + 4);
            const int chunk = 16 * bj + 4 * wc + fq;
#pragma unroll
            for (int ai = 0; ai < 2; ++ai)
#pragma unroll
                for (int m = 0; m < 4; ++m) { const int row = 128 * ai + 64 * wr + 16 * m + fr; f32x4 h0 = acc[ai][bj][m][0] + b0, h1 = acc[ai][bj][m][1] + b1;
#pragma unroll
                    for (int jj = 0; jj < 4; ++jj) { h0[jj] = h0[jj] * __builtin_amdgcn_rcpf(1.f + __builtin_amdgcn_exp2f(-LOG2E * h0[jj])); h1[jj] = h1[jj] * __builtin_amdgcn_rcpf(1.f + __builtin_amdgcn_exp2f(-LOG2E * h1[jj])); }
                    *(LAS u32x4*)(lds + row * 512 + ((chunk ^ (row & 15)) * 16)) = pack8(h0, h1); }
        }
        LDS_WAIT(); __builtin_amdgcn_s_barrier(); asm volatile("" ::: "memory");
        const int r32 = lane & 31, hi = lane >> 5; const int trow = 32 * wid + r32;
        f32x16 a2[2]; a2[0] = splat16(0.f); a2[1] = splat16(0.f);
        const bf16_t* wb = w2t + (size_t)j * 64 * 256;
#pragma unroll 4
        for (int ks = 0; ks < 16; ++ks) {
            const bf16x8 hb = *(const LAS bf16x8*)(lds + trow * 512 + (((2 * ks + hi) ^ (trow & 15)) * 16));
#pragma unroll
            for (int cb = 0; cb < 2; ++cb) { const bf16x8 wa = *(const bf16x8*)(wb + (size_t)(32 * cb + r32) * 256 + 16 * ks + 8 * hi);
                a2[cb] = __builtin_amdgcn_mfma_f32_32x32x16_bf16(wa, hb, a2[cb], 0, 0, 0); }
        }
        const int n = (u.pm & 1) * 256 + trow, bg = u.pm >> 1;
        if (j == 0) {
            float s = 0.f;
#pragma unroll
            for (int cb = 0; cb < 2; ++cb)
#pragma unroll
                for (int r = 0; r < 16; ++r) s += a2[cb][r] * a2[cb][r];
            s = half_swap_add(s);
            const float rs = __builtin_amdgcn_rsqf(s * (1.f / 64.f) + EPS);
#pragma unroll
            for (int cb = 0; cb < 2; ++cb)
#pragma unroll
                for (int r = 0; r < 16; ++r) a2[cb][r] *= rs * kgain[32 * cb + crow(r, hi)];
            const int pos = 16 * n + 31; const float* rp = rope + (size_t)(pos < T ? pos : T - 1) * 16;
#pragma unroll
            for (int r = 0; r < 4; ++r) { const int i = r + 4 * hi; const float c = rp[2 * i], sn = rp[2 * i + 1]; const float x1 = a2[0][r], x2 = a2[0][r + 4];
                a2[0][r] = x1 * c - x2 * sn; a2[0][r + 4] = x2 * c + x1 * sn; }
        }
        bf16_t* hb = (j == 0 ? KC : VC) + (size_t)bg * 512 * 64;
        const bool zero = n >= NCMP;
#pragma unroll
        for (int cb = 0; cb < 2; ++cb)
#pragma unroll
            for (int rq = 0; rq < 4; ++rq) { u32x2 o; o.x = pk2(a2[cb][4 * rq], a2[cb][4 * rq + 1]); o.y = pk2(a2[cb][4 * rq + 2], a2[cb][4 * rq + 3]); if (zero) { o.x = 0u; o.y = 0u; }
                const int d = 32 * cb + 8 * rq + 4 * hi;
                *(u32x2*)(hb + (j == 0 ? kimg_off(n, d) : vimg_off(n, d))) = o; }
    }
};

constexpr int N_PHASES = 21;
#if defined(__HIP_DEVICE_COMPILE__)
typedef const __attribute__((address_space(4))) Params* kparams_t;
__device__ __forceinline__ kparams_t kargs() { kparams_t p = (kparams_t)__builtin_amdgcn_kernarg_segment_ptr(); asm volatile("" : "+s"(p)); return p; }
#define KP(f) (kargs()->f)
#else
#define KP(f) (Params{}.f)
#endif
#define LOADP() Params P; { P.x = KP(x); P.p = KP(p); P.attn_norm = KP(attn_norm); P.ffn_norm = KP(ffn_norm); P.ple_norm = KP(ple_norm); P.ple_gate_w = KP(ple_gate_w); P.ple_proj_w = KP(ple_proj_w); \
    P.router_w = KP(router_w); P.router_b = KP(router_b); P.w_gu = KP(w_gu); P.b_gu = KP(b_gu); P.w_down = KP(w_down); P.b_down = KP(b_down); P.fox_w_in = KP(fox_w_in); P.fox_b_f = KP(fox_b_f); \
    P.fox_qk_gain = KP(fox_qk_gain); P.fox_w_out = KP(fox_w_out); P.kv_norm = KP(kv_norm); P.kv_w = KP(kv_w); P.kv_k_gain = KP(kv_k_gain); P.cmp_pos = KP(cmp_pos); P.cmp_w1 = KP(cmp_w1); P.cmp_w2 = KP(cmp_w2); \
    P.nsa_w_in = KP(nsa_w_in); P.nsa_q_gain = KP(nsa_q_gain); P.nsa_w_out = KP(nsa_w_out); P.out = KP(out); P.ws = KP(ws); P.ph_lo = 0; P.ph_hi = 0; } F.ws = P.ws

#define XB_TMO      128
#define XB_XCNT(j)  (256  + 64 * (j))
#define XB_XSUB(j)  (1280 + 64 * (j))
#define XB_XGEN(j)  (2304 + 64 * (j))
#define XB_TOP      3328
#define XB_TOPGEN   3392
#define XB_SPIN_CAP (1u << 22)
__device__ __forceinline__ unsigned xb_ld(unsigned* p)              { return __hip_atomic_load(p, __ATOMIC_RELAXED, __HIP_MEMORY_SCOPE_AGENT); }
__device__ __forceinline__ unsigned xb_add(unsigned* p, unsigned v) { return __hip_atomic_fetch_add(p, v, __ATOMIC_RELAXED, __HIP_MEMORY_SCOPE_AGENT); }
__device__ __forceinline__ unsigned xb_xcc_id() { return (unsigned)__builtin_amdgcn_s_getreg((3 << 11) | 20) & 0xFu; }
#define XB_SPIN(cond, bar) do { unsigned _sp = 0; while (cond) { __builtin_amdgcn_s_sleep(1); \
    if ((++_sp & 255u) == 0u) { if (xb_ld(&(bar)[XB_TMO])) break; if (_sp > XB_SPIN_CAP) { atomicAdd(&(bar)[XB_TMO], 1u); break; } } } } while (0)
__device__ __forceinline__ void xcd_barrier_post(unsigned* bar, int tid) { if (tid == 0) (void)xb_add(&bar[XB_XCNT(xb_xcc_id())], 1u); }
__device__ __forceinline__ void xcd_barrier_complete(unsigned* bar, unsigned x, unsigned& nloc, unsigned& nx) {
    const unsigned G = gridDim.x;
    unsigned sum, cnt, mine, sp = 0u;
    for (;;) {
        sum = 0u; cnt = 0u; mine = 0u;
#pragma unroll
        for (unsigned j = 0; j < 16; ++j) { const unsigned c = xb_ld(&bar[XB_XCNT(j)]); sum += c; cnt += (c > 0u) ? 1u : 0u; mine = (j == x) ? c : mine; }
        if (sum == G) break;
        __builtin_amdgcn_s_sleep(1);
        if ((++sp & 255u) == 0u) { if (xb_ld(&bar[XB_TMO])) break; if (sp > XB_SPIN_CAP) { atomicAdd(&bar[XB_TMO], 1u); break; } }
    }
    nloc = mine > 0u ? mine : 1u; nx = cnt > 0u ? cnt : 1u;
}
__device__ __forceinline__ void xcd_barrier(unsigned* bar, volatile LAS unsigned* st, int tid) {
    asm volatile("s_waitcnt vmcnt(0)" ::: "memory");
    __syncthreads();
    if (tid == 0) {
        const unsigned x = xb_xcc_id();
        __builtin_amdgcn_s_waitcnt(0);
        unsigned nloc = st[0], nx = st[1];
        if (nloc == 0u) { xcd_barrier_complete(bar, x, nloc, nx); st[0] = nloc; st[1] = nx; }
        const unsigned old = xb_add(&bar[XB_XSUB(x)], 1u);
        const unsigned gen = old / nloc;
        if (old + 1u == (gen + 1u) * nloc) {
            __builtin_amdgcn_fence(__ATOMIC_RELEASE, "agent");
            asm volatile("s_waitcnt vmcnt(0)" ::: "memory");
            const unsigned og = xb_add(&bar[XB_TOP], 1u);
            const unsigned tg = og / nx;
            if (og + 1u == (tg + 1u) * nx) xb_add(&bar[XB_TOPGEN], 1u);
            else XB_SPIN(xb_ld(&bar[XB_TOPGEN]) == tg, bar);
            __builtin_amdgcn_fence(__ATOMIC_ACQUIRE, "agent");
            xb_add(&bar[XB_XGEN(x)], 1u);
            asm volatile("s_waitcnt vmcnt(0)" ::: "memory");
        } else {
            XB_SPIN(xb_ld(&bar[XB_XGEN(x)]) == gen, bar);
            __builtin_amdgcn_fence(__ATOMIC_ACQUIRE, "agent");
            asm volatile("s_waitcnt vmcnt(0)" ::: "memory");
        }
    }
    __syncthreads();
}

__device__ __forceinline__ void pp_gemm(Frame& F, int l) {
    __syncthreads();
    int K5 = 256; asm volatile("" : "+s"(K5));
    DenseSched<BrowStd> S; S.init(WSP(bf16_t, WS_PBF) + (size_t)l * M * PLE, 512, WSP(bf16_t, WS_WPLEP) + (size_t)l * D * PLE, (size_t)256 * 256 * 2, (size_t)128 * 256 * 2, M, 4, F.G, F.bx);
    EpiBf16 E{WSP(bf16_t, WS_PP) + (size_t)l * M * D, D};
    gm::gemm_phase(F.lds, K5, S, E, F.tid);
}

extern __shared__ __attribute__((aligned(16))) unsigned char lds_raw[];
template <int PH>
__device__ __forceinline__ void run_phase(int wv) {
    Frame F;
    int tid_ = wv * 64 + lane_id_v(); asm volatile("" : "+v"(tid_));
    F.lds = (LAS unsigned char*)lds_raw; F.tid = tid_; F.lane = F.tid & 63; F.wave = __builtin_amdgcn_readfirstlane(F.tid >> 6);
    int bx = blockIdx.x; asm volatile("" : "+s"(bx));
    F.G = gridDim.x; F.vcu = (F.G % 8 == 0) ? (bx % 8) * (F.G / 8) + bx / 8 : bx; F.bx = bx;
    F.gw = F.vcu * NWAVES + F.wave; F.NGW = F.G * NWAVES;
    LOADP();
    bf16_t* XB = WSP(bf16_t, WS_XB);
    constexpr int layer = (PH >= 16) ? 1 : 0;
    constexpr int ph = (PH >= 16) ? PH - 10 : PH;
    LAS int* tstart = (LAS int*)(F.lds + LDS_MISC); LAS int* ecnt = tstart + 64;
    if constexpr (PH == 0) { phase_prologue(F, P); }
    else if constexpr (PH == 1) { phase_fox_pre(F, P); }
    else if constexpr (PH == 2) {
        if (F.vcu < NB * NH) fox_scan(F, F.vcu);
        DenseSched<BrowHead> S; S.init(WSP(bf16_t, WS_XN), 2048, WSP(bf16_t, WS_WFOXIN), (size_t)256 * 1024 * 2, (size_t)32 * 1024 * 2, M, 12, F.G, F.bx);
        EpiFoxQKV E{WSP(bf16_t, WS_Q), P.fox_qk_gain};
        gm::gemm_phase(F.lds, 1024, S, E, F.tid);
    }
    else if constexpr (PH == 3) { phase_fox_attn(F, P); }
    else if constexpr (PH == 4) {
        DenseSched<BrowStd> S; S.init(WSP(bf16_t, WS_O), 2048, WSP(bf16_t, WS_WFOXOUT), (size_t)256 * 1024 * 2, (size_t)128 * 1024 * 2, M, 4, F.G, F.bx);
        EpiResid<float> E{P.x, XB};
        gm::gemm_phase(F.lds, 1024, S, E, F.tid);
        pp_gemm(F, 0);
    }
    else if constexpr (PH == 5) { }
    else if constexpr (ph == 6) {
#if defined(PROBE_ROUTE)
        phase_moe_route(F, P, layer, XB, 2 + layer); __syncthreads();
#endif
        phase_moe_route(F, P, layer, XB); }
    else if constexpr (ph == 7) {
        const int ntot = moe_tables(F, layer, tstart, ecnt);
        MoeSched S; S.A = (const char*)WSP(unsigned char, WS_XN8); S.list = WSP(int, WS_LIST); S.Bt = (const char*)(WSP(unsigned char, WS_WGU) + (size_t)layer * NE * 2048 * 1024); S.estride = (size_t)2048 * 1024;
        S.tstepB_ = (size_t)128 * 1024; S.hstepB_ = (size_t)1024 * 1024; S.npn = 8; S.G = F.G; S.c = F.vcu; S.ntot = ntot; S.gather = true; S.tstart = tstart; S.ecnt = ecnt;
        EpiSwiglu E{WSP(unsigned char, WS_H), P.b_gu + (size_t)layer * NE * 2048};
        int K8 = 512; asm volatile("" : "+s"(K8)); gm::gemm_phase<true>(F.lds, K8, S, E, F.tid);
    }
    else if constexpr (ph == 8) {
        const int ntot = moe_tables(F, layer, tstart, ecnt);
        MoeSched S; S.A = (const char*)WSP(unsigned char, WS_H); S.list = nullptr; S.Bt = (const char*)(WSP(unsigned char, WS_WDN) + (size_t)layer * NE * 1024 * 1024); S.estride = (size_t)1024 * 1024;
        S.tstepB_ = (size_t)256 * 1024; S.hstepB_ = (size_t)128 * 1024; S.npn = 4; S.G = F.G; S.c = F.vcu; S.ntot = ntot; S.gather = false; S.tstart = tstart; S.ecnt = ecnt;
        EpiDown E{WSP(unsigned char, WS_Y), P.b_down + (size_t)layer * NE * D, WSP(float, WS_GL)};
        int K8 = 512; asm volatile("" : "+s"(K8)); gm::gemm_phase<true>(F.lds, K8, S, E, F.tid);
    }
    else if constexpr (ph == 9) { phase_moe_combine(F, layer, XB); }
    else if constexpr (ph == 10) {
        DenseSched<BrowStd> S; S.init(WSP(unsigned char, WS_XN8), 1024, WSP(unsigned char, WS_WPLEG) + (size_t)layer * D * D, (size_t)256 * 1024, (size_t)128 * 1024, M, 4, F.G, F.bx);
        int K8 = 512; asm volatile("" : "+s"(K8));
        if constexpr (layer == 1) { EpiPle<float> E{XB, P.out, WSP(bf16_t, WS_PP) + (size_t)layer * M * D}; gm::gemm_phase<true>(F.lds, K8, S, E, F.tid); }
        else { EpiPle<bf16_t> E{XB, XB, WSP(bf16_t, WS_PP) + (size_t)layer * M * D}; gm::gemm_phase<true>(F.lds, K8, S, E, F.tid); }
    }
    else if constexpr (PH == 11) { phase_nsa_pre(F); }
    else if constexpr (PH == 12) {
        DenseSched<BrowHead> S; S.init(WSP(bf16_t, WS_XB), 2048, WSP(bf16_t, WS_WNSA), (size_t)256 * 1024 * 2, (size_t)32 * 1024 * 2, M, 10, F.G, F.bx);
        EpiNsaKVQ E{WSP(bf16_t, WS_Q), WSP(bf16_t, WS_ZK), P.kv_k_gain, P.nsa_q_gain, WSP(float, WS_ROPE), WSP(float, WS_RSTD)};
        gm::gemm_phase(F.lds, 1024, S, E, F.tid);
        if (F.G == 256 && F.bx >= 128) { __syncthreads(); convert_moe_l1(F, P, F.bx - 128, 128, 0, L1_SPLIT); }

    }
    else if constexpr (PH == 13) {
        CmpSched S; S.A = (const char*)WSP(bf16_t, WS_ZK); S.Bt = (const char*)WSP(bf16_t, WS_WC1); S.G = F.G; S.c = F.vcu;
        EpiCompress E{WSP(float, WS_CB1), WSP(bf16_t, WS_WC2), P.kv_k_gain, WSP(float, WS_ROPE), WSP(bf16_t, WS_KC), WSP(bf16_t, WS_VC)};
        if (F.vcu < 32 || F.G <= 32) gm::gemm_phase(F.lds, 2048, S, E, F.tid);
        const int lo = (F.G == 256) ? L1_SPLIT : 0;
        if (F.vcu >= 32) convert_moe_l1(F, P, F.vcu - 32, F.G - 32, lo, L1_ITEMS);
        else if (F.G <= 32) convert_moe_l1(F, P, F.vcu, F.G, lo, L1_ITEMS);
    }
    else if constexpr (PH == 14) { phase_nsa_attn(F, P); }
    else if constexpr (PH == 15) {
        DenseSched<BrowStd> S; S.init(WSP(bf16_t, WS_O), 2048, WSP(bf16_t, WS_WNSAOUT), (size_t)256 * 1024 * 2, (size_t)128 * 1024 * 2, M, 4, F.G, F.bx);
        EpiResid<bf16_t> E{XB, XB};
        gm::gemm_phase(F.lds, 1024, S, E, F.tid);
        pp_gemm(F, 1);
    }
}
template <int K, int HI>
__device__ __forceinline__ void run_range(int wv) {
    if constexpr (K == 5) { if constexpr (K + 1 < HI) run_range<K + 1, HI>(wv); return; }
    run_phase<K>(wv);
    if constexpr ((REPEAT_MASK >> K) & 1u) { int tid = wv * 64 + lane_id_v(); asm volatile("" : "+v"(tid)); xcd_barrier((unsigned*)(KP(ws) + WS_CTL) + CW_BAR, (volatile LAS unsigned*)((LAS unsigned char*)lds_raw + LDS_MISC + 512), tid); run_phase<K>(wv); }
    if constexpr (K + 1 < HI) {
        { int tid = wv * 64 + lane_id_v(); asm volatile("" : "+v"(tid)); xcd_barrier((unsigned*)(KP(ws) + WS_CTL) + CW_BAR, (volatile LAS unsigned*)((LAS unsigned char*)lds_raw + LDS_MISC + 512), tid); }
        run_range<K + 1, HI>(wv);
    }
}
template <int LO, int HI>
__global__ void __launch_bounds__(NTHREADS, 2) __attribute__((target("no-packed-fp32-ops"))) mega(Params P_) {
    const int wv = __builtin_amdgcn_readfirstlane((int)threadIdx.x >> 6);
    if constexpr (HI - LO > 1) {
        if (KP(ph_hi) < 0) cg::this_grid().sync();
        int tid = wv * 64 + lane_id_v(); asm volatile("" : "+v"(tid));
        volatile LAS unsigned* st = (volatile LAS unsigned*)((LAS unsigned char*)lds_raw + LDS_MISC + 512);
        if (tid < 2) st[tid] = 0u;
        __syncthreads();
        xcd_barrier_post((unsigned*)(KP(ws) + WS_CTL) + CW_BAR, tid);
    }
    run_range<LO, HI>(wv);
}

#if N_LAUNCH_MODE == 1
#define FULLK (mega<0, N_PHASES>)
static void set_attrs() { (void)hipFuncSetAttribute((const void*)FULLK, hipFuncAttributeMaxDynamicSharedMemorySize, LDS_BYTES); }
#else
#define FULLK (mega<0, 1>)
template <int K> static void set_attr1() { (void)hipFuncSetAttribute((const void*)(mega<K, K + 1>), hipFuncAttributeMaxDynamicSharedMemorySize, LDS_BYTES); if constexpr (K + 1 < N_PHASES) set_attr1<K + 1>(); }
static void set_attrs() { set_attr1<0>(); }
template <int K> static void launch_all(const Params& P, int grid, hipStream_t stream) {
    hipLaunchKernelGGL((mega<K, K + 1>), dim3(grid), dim3(NTHREADS), LDS_BYTES, stream, P);
    if constexpr (K + 1 < N_PHASES) launch_all<K + 1>(P, grid, stream);
}
#endif
extern "C" void kernel_launch(void* const* d_in, const int* in_sizes, int n_in, void* d_out, int out_size, void* d_ws, size_t ws_size, hipStream_t stream) {
    static int grid = 0;
    if (grid == 0) {
        if (n_in != 26 || ws_size < WS_END) { fprintf(stderr, "kernel_launch: unexpected inputs (n_in %d, ws %zu, need %zu)\n", n_in, ws_size, (size_t)WS_END); grid = -1; return; }
        int dev = 0, cus = 0, per_cu = 0;
        hipGetDevice(&dev); hipDeviceGetAttribute(&cus, hipDeviceAttributeMultiprocessorCount, dev);
        set_attrs();
        hipOccupancyMaxActiveBlocksPerMultiprocessor(&per_cu, (const void*)FULLK, NTHREADS, LDS_BYTES);
        (void)hipGetLastError();
        if (per_cu < 1) { fprintf(stderr, "kernel_launch: occupancy query says %d blocks/CU\n", per_cu); grid = -1; return; }
        grid = cus;
    }
    if (grid < 0) return;
    hipMemsetAsync((char*)d_ws + WS_CTL, 0, CTL_BYTES, stream);
    Params P{};
    const float** pp = (const float**)&P;
    for (int i = 0; i < 26; ++i) pp[i] = (const float*)d_in[i];
    P.out = (float*)d_out; P.ws = (unsigned char*)d_ws;
#if N_LAUNCH_MODE == 1
    P.ph_lo = 0; P.ph_hi = N_PHASES;
    void* args[] = {&P};
    hipError_t e = hipLaunchCooperativeKernel((const void*)FULLK, dim3(grid), dim3(NTHREADS), args, LDS_BYTES, stream);
    if (e != hipSuccess) fprintf(stderr, "cooperative launch failed: %s (grid %d)\n", hipGetErrorString(e), grid);
#else
    launch_all<0>(P, grid, stream);
#endif
}
```

```cpp
#include <hip/hip_runtime.h>
#include <hip/hip_cooperative_groups.h>
#include <cstdint>
#include <cstdio>
namespace cg = cooperative_groups;

#ifndef REPEAT_MASK
#define REPEAT_MASK 0u
#endif
#ifndef N_LAUNCH_MODE
#define N_LAUNCH_MODE 1
#endif

#define LAS __attribute__((address_space(3)))
typedef unsigned short bf16_t;
typedef short bf16x8 __attribute__((ext_vector_type(8)));
typedef short s16x4 __attribute__((ext_vector_type(4)));
typedef float f32x2 __attribute__((ext_vector_type(2)));
typedef float f32x4 __attribute__((ext_vector_type(4)));
typedef float f32x16 __attribute__((ext_vector_type(16)));
typedef unsigned u32x2 __attribute__((ext_vector_type(2)));
typedef unsigned u32x4 __attribute__((ext_vector_type(4)));
typedef int i32x8 __attribute__((ext_vector_type(8)));
typedef int i32x4 __attribute__((ext_vector_type(4)));

constexpr int NB = 2, T = 8192, D = 1024, M = NB * T, NH = 16, HD = 64, NG = 4, HPG = 4;
constexpr int PLE = 256, NE = 32, TOPK = 4, FF = 1024;
constexpr int NCMP = 511, NSEL = 128, SELTOP = 16, WIN = 512;
constexpr int FOXN = 3 * NH * HD + NH;
constexpr int NSAN = NH * HD + 3 * NH;
constexpr int KVN = 6 * NG * HD;
constexpr float EPS = 1e-6f;
constexpr float LOG2E = 1.4426950408889634f;
constexpr float C2 = 0.125f * LOG2E;
constexpr int MOE_ROWS = M * TOPK + NE * 256;
constexpr int NWAVES = 8, NTHREADS = 512;

constexpr size_t MiB = 1u << 20;
constexpr size_t al(size_t x) { return (x + 4095) & ~(size_t)4095; }
constexpr size_t WS_CTL = 0, CTL_BYTES = 1 * MiB, CTL_USED_BYTES = 128 * 1024;
constexpr size_t WS_ROPE = WS_CTL + CTL_BYTES;
constexpr size_t WS_WFT = WS_ROPE + (size_t)T * 8 * 2 * 4;
constexpr size_t WS_WRT = WS_WFT + 32 * 1024 * 4;
constexpr size_t WS_WGT = WS_WRT + 2 * 32 * 1024 * 4;
constexpr size_t WS_CB1 = WS_WGT + 64 * 1024 * 4;
constexpr size_t WS_RSTD = al(WS_CB1 + 2 * 256 * 4);
constexpr size_t WS_LOGF = WS_RSTD + (size_t)M * 4;
constexpr size_t WS_BIAS = WS_LOGF + (size_t)NB * NH * T * 4;
constexpr size_t WS_KAUG = WS_BIAS + (size_t)NB * NH * T * 4;
constexpr size_t WS_GATES = WS_KAUG + (size_t)NB * NH * T * 16;
constexpr size_t WS_TOKINFO = WS_GATES + (size_t)M * 48 * 4;
constexpr size_t WS_LIST = WS_TOKINFO + (size_t)M * 4 * 4;
constexpr size_t WS_GL = WS_LIST + (size_t)NE * M * 4;
constexpr size_t WS_WFOXIN = al(WS_GL + (size_t)NE * M * 4);
constexpr size_t WS_WFOXOUT = WS_WFOXIN + (size_t)3072 * 1024 * 2;
constexpr size_t WS_WNSA = WS_WFOXOUT + (size_t)1024 * 1024 * 2;
constexpr size_t WS_WNSAOUT = WS_WNSA + (size_t)2560 * 1024 * 2;
constexpr size_t WS_WPLEG = WS_WNSAOUT + (size_t)1024 * 1024 * 2;
constexpr size_t WS_WPLEP = WS_WPLEG + (size_t)2 * 1024 * 1024 * 2;
constexpr size_t WS_WC1 = WS_WPLEP + (size_t)2 * 1024 * 256 * 2;
constexpr size_t WS_WC2 = WS_WC1 + (size_t)2 * 256 * 2048 * 2;
constexpr size_t WS_WGU = al(WS_WC2 + (size_t)2 * 64 * 256 * 2);
constexpr size_t WS_WDN = WS_WGU + (size_t)2 * 32 * 2048 * 1024 * 2;
constexpr size_t WS_XB = WS_WDN + (size_t)2 * 32 * 1024 * 1024 * 2;
constexpr size_t WS_XN = WS_XB + (size_t)M * D * 4;
constexpr size_t WS_Q = WS_XN + (size_t)M * D * 2;
constexpr size_t WS_K = WS_Q + (size_t)M * D * 2;
constexpr size_t WS_V = WS_K + (size_t)M * D * 2;
constexpr size_t WS_O = WS_V + (size_t)M * D * 2;
constexpr size_t NSA_HEADBUF = (size_t)NB * NG * T * HD * 2;
constexpr size_t KV6_STRIDE = NSA_HEADBUF + 8192;
constexpr size_t WS_ZK = WS_O + (size_t)M * D * 2;
constexpr size_t WS_ZV = WS_ZK + KV6_STRIDE;
constexpr size_t WS_KS = WS_ZV + KV6_STRIDE;
constexpr size_t WS_VS = WS_KS + KV6_STRIDE;
constexpr size_t WS_KW = WS_VS + KV6_STRIDE;
constexpr size_t WS_VW = WS_KW + KV6_STRIDE;
constexpr size_t WS_KC = WS_VW + KV6_STRIDE;
constexpr size_t WS_VC = WS_KC + (size_t)8 * 512 * 64 * 2;
constexpr size_t WS_PBF = WS_VC + (size_t)8 * 512 * 64 * 2;
constexpr size_t WS_PP = WS_PBF + (size_t)2 * M * PLE * 2;
constexpr size_t WS_H = WS_PP + (size_t)2 * M * D * 2;
constexpr size_t WS_Y = WS_H + (size_t)MOE_ROWS * FF * 2;
constexpr size_t WS_XN8 = WS_Y + (size_t)MOE_ROWS * D * 2;
constexpr size_t WS_END = WS_XN8 + (size_t)M * D;

constexpr int CW_CNT = 16384, CNT_STRIDE = 64;
constexpr int CW_BAR = 4096;

constexpr int RING_BYTES = 131072;
constexpr int LDS_BYTES = 147456;
constexpr int LDS_MISC = LDS_BYTES - 2048;

__device__ __forceinline__ unsigned f2bf(float f) { unsigned u = __builtin_bit_cast(unsigned, f); return (u + 0x7fffu + ((u >> 16) & 1u)) >> 16; }
typedef __bf16 bf16x2_t __attribute__((ext_vector_type(2)));
__device__ __forceinline__ unsigned pk2(float lo, float hi) { f32x2 v = {lo, hi}; bf16x2_t b = __builtin_convertvector(v, bf16x2_t); return __builtin_bit_cast(unsigned, b); }
__device__ __forceinline__ unsigned pk4_fp8(float a, float b, float c, float d) { int w = __builtin_amdgcn_cvt_pk_fp8_f32(a, b, 0, false); w = __builtin_amdgcn_cvt_pk_fp8_f32(c, d, w, true); return (unsigned)w; }
constexpr float W8_SCALE = 32.f, W8_INV = 1.f / 32.f, Y8_SCALE = 16.f, Y8_INV = 1.f / 16.f;
__device__ __forceinline__ f32x4 ld4(const float* p) { return *(const f32x4*)p; }
__device__ __forceinline__ f32x4 ld4(const bf16_t* p) { const u32x2 w = *(const u32x2*)p; return (f32x4){__builtin_bit_cast(float, w.x << 16), __builtin_bit_cast(float, w.x & 0xffff0000u), __builtin_bit_cast(float, w.y << 16), __builtin_bit_cast(float, w.y & 0xffff0000u)}; }
__device__ __forceinline__ void ld8(const float* p, f32x4& a, f32x4& b) { a = *(const f32x4*)p; b = *(const f32x4*)(p + 4); }
__device__ __forceinline__ void ld8(const bf16_t* p, f32x4& a, f32x4& b) { const u32x4 w = *(const u32x4*)p;
    a = (f32x4){__builtin_bit_cast(float, w.x << 16), __builtin_bit_cast(float, w.x & 0xffff0000u), __builtin_bit_cast(float, w.y << 16), __builtin_bit_cast(float, w.y & 0xffff0000u)};
    b = (f32x4){__builtin_bit_cast(float, w.z << 16), __builtin_bit_cast(float, w.z & 0xffff0000u), __builtin_bit_cast(float, w.w << 16), __builtin_bit_cast(float, w.w & 0xffff0000u)}; }
__device__ __forceinline__ void st8(float* p, const f32x4 a, const f32x4 b) { *(f32x4*)p = a; *(f32x4*)(p + 4) = b; }
__device__ __forceinline__ void st4(float* p, const f32x4 v) { *(f32x4*)p = v; }
__device__ __forceinline__ void st4(bf16_t* p, const f32x4 v) { u32x2 o; o.x = pk2(v[0], v[1]); o.y = pk2(v[2], v[3]); *(u32x2*)p = o; }
__device__ __forceinline__ float bf2f(unsigned short b) { return __builtin_bit_cast(float, (unsigned)b << 16); }
#define DPPF(v, ctrl, rm) __uint_as_float(__builtin_amdgcn_update_dpp(0u, __float_as_uint(v), ctrl, rm, 0xF, true))
__device__ __forceinline__ float wave_sum(float v) {
    v += DPPF(v, 0xB1, 0xF); v += DPPF(v, 0x4E, 0xF); v += DPPF(v, 0x141, 0xF); v += DPPF(v, 0x140, 0xF);
    { auto r = __builtin_amdgcn_permlane16_swap(__float_as_uint(v), __float_as_uint(v), false, false); v = __uint_as_float(r[0]) + __uint_as_float(r[1]); }
    { auto r = __builtin_amdgcn_permlane32_swap(__float_as_uint(v), __float_as_uint(v), false, false); v = __uint_as_float(r[0]) + __uint_as_float(r[1]); }
    return v;
}
__device__ __forceinline__ float wave_max(float v) {
    v = fmaxf(v, DPPF(v, 0xB1, 0xF)); v = fmaxf(v, DPPF(v, 0x4E, 0xF)); v = fmaxf(v, DPPF(v, 0x141, 0xF)); v = fmaxf(v, DPPF(v, 0x140, 0xF));
    { auto r = __builtin_amdgcn_permlane16_swap(__float_as_uint(v), __float_as_uint(v), false, false); v = fmaxf(__uint_as_float(r[0]), __uint_as_float(r[1])); }
    { auto r = __builtin_amdgcn_permlane32_swap(__float_as_uint(v), __float_as_uint(v), false, false); v = fmaxf(__uint_as_float(r[0]), __uint_as_float(r[1])); }
    return v;
}
__device__ __forceinline__ float wave_scan_f(float v) {
    v += DPPF(v, 0x111, 0xF); v += DPPF(v, 0x112, 0xF); v += DPPF(v, 0x114, 0xF); v += DPPF(v, 0x118, 0xF);
    v += DPPF(v, 0x142, 0xA); v += DPPF(v, 0x143, 0xC);
    return v;
}
__device__ __forceinline__ f32x16 splat16z() { f32x16 r;
#pragma unroll
    for (int i = 0; i < 16; ++i) r[i] = 0.f; return r; }
__device__ __forceinline__ int lane_id() { return (int)__builtin_amdgcn_mbcnt_hi(~0u, __builtin_amdgcn_mbcnt_lo(~0u, 0u)); }
__device__ __forceinline__ int lane_id_v() { int l; asm volatile("v_mbcnt_lo_u32_b32 %0, -1, 0\n\tv_mbcnt_hi_u32_b32 %0, -1, %0" : "=v"(l)); return l; }
__device__ __forceinline__ float xor32_other(float v) { auto r = __builtin_amdgcn_permlane32_swap(__float_as_uint(v), __float_as_uint(v), false, false); return __uint_as_float(((lane_id() >> 5) & 1) ? r[0] : r[1]); }
__device__ __forceinline__ float xor32_sum(float v) { auto r = __builtin_amdgcn_permlane32_swap(__float_as_uint(v), __float_as_uint(v), false, false); return __uint_as_float(r[0]) + __uint_as_float(r[1]); }
__device__ __forceinline__ float xor16_sum(float v) { auto r = __builtin_amdgcn_permlane16_swap(__float_as_uint(v), __float_as_uint(v), false, false); return __uint_as_float(r[0]) + __uint_as_float(r[1]); }
__device__ __forceinline__ float xor8_sum(float v) { return v + __uint_as_float(__builtin_amdgcn_update_dpp(0u, __float_as_uint(v), 0x128, 0xF, 0xF, true)); }
__device__ __forceinline__ unsigned max8_u32(unsigned v) {
    v = max(v, (unsigned)__builtin_amdgcn_update_dpp(0u, v, 0xB1, 0xF, 0xF, true));
    v = max(v, (unsigned)__builtin_amdgcn_update_dpp(0u, v, 0x4E, 0xF, 0xF, true));
    v = max(v, (unsigned)__builtin_amdgcn_update_dpp(0u, v, 0x141, 0xF, 0xF, true));
    return v;
}
__device__ __forceinline__ float xor16_other(float v) { auto r = __builtin_amdgcn_permlane16_swap(__float_as_uint(v), __float_as_uint(v), false, false); return __uint_as_float(((lane_id() >> 4) & 1) ? r[0] : r[1]); }
#define LDS_WAIT() asm volatile("s_waitcnt lgkmcnt(0)" ::: "memory")
#define VM_WAIT() asm volatile("s_waitcnt vmcnt(0)" ::: "memory")

struct Params {
    const float* x; const float* p; const float* attn_norm; const float* ffn_norm; const float* ple_norm;
    const float* ple_gate_w; const float* ple_proj_w; const float* router_w; const float* router_b;
    const float* w_gu; const float* b_gu; const float* w_down; const float* b_down;
    const float* fox_w_in; const float* fox_b_f; const float* fox_qk_gain; const float* fox_w_out;
    const float* kv_norm; const float* kv_w; const float* kv_k_gain; const float* cmp_pos; const float* cmp_w1; const float* cmp_w2;
    const float* nsa_w_in; const float* nsa_q_gain; const float* nsa_w_out;
    float* out; unsigned char* ws;
    int ph_lo, ph_hi;
};

namespace gm {
template <bool F8> struct FragT { struct A4 { bf16x8 v[4][2]; }; struct B2 { bf16x8 v[2][2]; }; };
template <> struct FragT<true> { struct A4 { i32x8 v[4]; }; struct B2 { i32x8 v[2]; }; };
constexpr int BM = 256, BK = 64, HALF = 128, HTB = HALF * BK * 2, STAGE_BYTES = 8 * HTB;
__host__ __device__ __forceinline__ int lds_byte(int r, int c) { const int st = (r >> 4) * 2 + (c >> 5), rr = r & 15, cc = c & 31, ob = rr * 64 + cc * 2; return st * 1024 + (ob ^ (((ob >> 9) & 1) << 5)); }
__host__ __device__ __forceinline__ void stage_rc(int b, int& R, int& C) { const int st = b / 1024, sb = b % 1024, swz = sb ^ (((sb >> 9) & 1) << 5); R = (st >> 1) * 16 + swz / 64; C = (st & 1) * 32 + (swz % 64) / 2; }
__host__ __device__ __forceinline__ int perm32(int rho) { const int n = rho >> 4, i = rho & 15; return 8 * (i >> 2) + 4 * n + (i & 3); }

struct Unit { int pm, pn, aux, cnt; };

template <bool F8 = false, class Epi, class Sched>
__device__ __forceinline__ void gemm_phase(LAS unsigned char* lds, const int K, const Sched& S, const Epi& E, const int tid) {
    const int wid = __builtin_amdgcn_readfirstlane(tid >> 6), lane = tid & 63, wr = wid >> 2, wc = wid & 3, fr = lane & 15, fq = lane >> 4;
    const int nt = K / BK;
    int Rl0, Cl0; stage_rc(tid * 16, Rl0, Cl0);
    const int Rl[2] = {Rl0, Rl0 + 64}, Cl[2] = {Cl0, Cl0}; unsigned voffB[2];
#pragma unroll
    for (int i = 0; i < 2; ++i) voffB[i] = (unsigned)(Sched::brow(Rl[i]) * K + Cl[i]) * 2u;
    const size_t kstep = (size_t)(BK * 2);
    const size_t hstepB = S.hstepB();
    const unsigned ldsw = (unsigned)wid * 1024u;
    const int aoff = lds_byte(wr * 64 + fr, F8 ? fq * 16 : fq * 8), boff = lds_byte(wc * 32 + fr, F8 ? fq * 16 : fq * 8);
    const int aoff1 = aoff + (F8 ? 16 : 1024), boff1 = boff + (F8 ? 16 : 1024);
#define G_SA(b, h) (((b) * 2 + (h)) * HTB)
#define G_SB(b, h) ((4 + (b) * 2 + (h)) * HTB)
#define G_STAGE(bufoff, gbase, v0, v1) do { \
        __builtin_amdgcn_global_load_lds((const unsigned*)((const char*)(gbase) + (v0)), (LAS unsigned*)(lds + (bufoff) + ldsw), 16, 0, 0); \
        __builtin_amdgcn_global_load_lds((const unsigned*)((const char*)(gbase) + (v1)), (LAS unsigned*)(lds + (bufoff) + ldsw + 8192), 16, 0, 0); } while (0)
#define G_LDA(dst, b, h) do { _Pragma("unroll") for (int m = 0; m < 4; ++m) { \
        if constexpr (F8) { const i32x4 lo_ = *(const LAS i32x4*)(lds + G_SA(b, h) + aoff + m * 2048), hi_ = *(const LAS i32x4*)(lds + G_SA(b, h) + aoff1 + m * 2048); dst.v[m] = __builtin_shufflevector(lo_, hi_, 0, 1, 2, 3, 4, 5, 6, 7); } \
        else { _Pragma("unroll") for (int k = 0; k < 2; ++k) dst.v[m][k] = *(const LAS bf16x8*)(lds + G_SA(b, h) + (k ? aoff1 : aoff) + m * 2048); } } } while (0)
#define G_LDB(dst, b, h) do { _Pragma("unroll") for (int n = 0; n < 2; ++n) { \
        if constexpr (F8) { const i32x4 lo_ = *(const LAS i32x4*)(lds + G_SB(b, h) + boff + n * 2048), hi_ = *(const LAS i32x4*)(lds + G_SB(b, h) + boff1 + n * 2048); dst.v[n] = __builtin_shufflevector(lo_, hi_, 0, 1, 2, 3, 4, 5, 6, 7); } \
        else { _Pragma("unroll") for (int k = 0; k < 2; ++k) dst.v[n][k] = *(const LAS bf16x8*)(lds + G_SB(b, h) + (k ? boff1 : boff) + n * 2048); } } } while (0)
#define G_MMA(ai, bj, At, Bt) do { __builtin_amdgcn_s_setprio(1); _Pragma("unroll") for (int m = 0; m < 4; ++m) _Pragma("unroll") for (int n = 0; n < 2; ++n) { \
        if constexpr (F8) { asm volatile("v_mfma_f32_16x16x128_f8f6f4 %0, %1, %2, %0" : "+v"(acc[ai][bj][m][n]) : "v"(Bt.v[n]), "v"(At.v[m])); } \
        else { _Pragma("unroll") for (int k = 0; k < 2; ++k) acc[ai][bj][m][n] = __builtin_amdgcn_mfma_f32_16x16x32_bf16(Bt.v[n][k], At.v[m][k], acc[ai][bj][m][n], 0, 0, 0); } } \
        __builtin_amdgcn_s_setprio(0); } while (0)
#define G_WAIT_V(n) asm volatile("s_waitcnt vmcnt(" #n ")" ::: "memory")
#define G_WAIT_L(n) asm volatile("s_waitcnt lgkmcnt(" #n ")" ::: "memory")
#define G_BAR __builtin_amdgcn_s_barrier()
#define G_SCHED __builtin_amdgcn_sched_barrier(0)
    Unit cur, nxt; int ui = 0;
    if (!S.next(0, cur)) return;
    f32x4 acc[2][2][4][2];
#pragma unroll
    for (int a = 0; a < 2; ++a)
#pragma unroll
        for (int b = 0; b < 2; ++b)
#pragma unroll
            for (int m = 0; m < 4; ++m)
#pragma unroll
                for (int n = 0; n < 2; ++n) acc[a][b][m][n] = (f32x4){0.f, 0.f, 0.f, 0.f};
    typedef typename FragT<F8>::A4 FA; typedef typename FragT<F8>::B2 FB;
    FA At; FB B0, B1;
    const char* const Ab = S.a_base();
    const char* cB = S.b_base(cur);
    unsigned cA00 = S.a_off(cur, Rl[0]) + Cl[0] * 2, cA01 = S.a_off(cur, Rl[1]) + Cl[1] * 2, cA10 = S.a_off(cur, 128 + Rl[0]) + Cl[0] * 2, cA11 = S.a_off(cur, 128 + Rl[1]) + Cl[1] * 2;
    G_STAGE(G_SB(0, 0), cB, voffB[0], voffB[1]); G_STAGE(G_SB(0, 1), cB + hstepB, voffB[0], voffB[1]); G_STAGE(G_SA(0, 0), Ab, cA00, cA01); G_STAGE(G_SA(0, 1), Ab, cA10, cA11);
    if (wr == 1) G_BAR;
    G_WAIT_V(2); G_BAR;
    G_STAGE(G_SB(1, 0), cB + kstep, voffB[0], voffB[1]); G_STAGE(G_SA(1, 0), Ab + kstep, cA00, cA01); G_STAGE(G_SB(1, 1), cB + hstepB + kstep, voffB[0], voffB[1]);
    G_WAIT_V(6); G_BAR;
    for (;;) {
        const bool has_next = S.next(ui + 1, nxt);
        const char* nB = has_next ? S.b_base(nxt) : cB;
        unsigned nA00 = cA00, nA01 = cA01, nA10 = cA10, nA11 = cA11;
        if (has_next) { nA00 = S.a_off(nxt, Rl[0]) + Cl[0] * 2; nA01 = S.a_off(nxt, Rl[1]) + Cl[1] * 2; nA10 = S.a_off(nxt, 128 + Rl[0]) + Cl[0] * 2; nA11 = S.a_off(nxt, 128 + Rl[1]) + Cl[1] * 2; }
        for (int t = 0; t < nt; t += 2) {
            const bool last = (t == nt - 2);
            const char* a1 = Ab + (size_t)(t + 1) * kstep;
            const char* a2 = last ? Ab : Ab + (size_t)(t + 2) * kstep; const char* b2 = last ? nB : cB + (size_t)(t + 2) * kstep;
            const char* a3 = a2 + kstep; const char* b3 = b2 + kstep;
            const unsigned x00 = last ? nA00 : cA00, x01 = last ? nA01 : cA01, x10 = last ? nA10 : cA10, x11 = last ? nA11 : cA11;
            G_LDB(B0, 0, 0); G_LDB(B1, 0, 1); G_SCHED; G_LDA(At, 0, 0); G_STAGE(G_SA(1, 1), a1, cA10, cA11);
            G_WAIT_V(8); G_WAIT_L(0); G_BAR; G_MMA(0, 0, At, B0); G_MMA(0, 1, At, B1); G_BAR; G_SCHED;
            G_LDA(At, 0, 1); G_STAGE(G_SB(0, 0), b2, voffB[0], voffB[1]); G_STAGE(G_SB(0, 1), b2 + hstepB, voffB[0], voffB[1]); G_STAGE(G_SA(0, 0), a2, x00, x01);
            G_WAIT_V(8); G_WAIT_L(0); G_BAR; G_MMA(1, 0, At, B0); G_MMA(1, 1, At, B1); G_BAR; G_SCHED;
            G_LDB(B0, 1, 0); G_LDB(B1, 1, 1); G_SCHED; G_LDA(At, 1, 0); G_STAGE(G_SA(0, 1), a2, x10, x11);
            G_WAIT_V(8); G_WAIT_L(0); G_BAR; G_MMA(0, 0, At, B0); G_MMA(0, 1, At, B1); G_BAR; G_SCHED;
            G_LDA(At, 1, 1); G_STAGE(G_SB(1, 0), b3, voffB[0], voffB[1]); G_STAGE(G_SB(1, 1), b3 + hstepB, voffB[0], voffB[1]); G_STAGE(G_SA(1, 0), a3, x00, x01);
            G_WAIT_V(8); G_WAIT_L(0); G_BAR; G_MMA(1, 0, At, B0); G_MMA(1, 1, At, B1); G_BAR; G_SCHED;
        }
        if constexpr (F8) asm volatile("s_nop 15\n\ts_nop 15" ::: "memory");
        if (wr == 0) G_BAR;
        if constexpr (!Epi::AFTER_DRAIN) { E(acc, cur, wr, wc, fr, fq); }
        if (!has_next) break;
#pragma unroll
        for (int a = 0; a < 2; ++a)
#pragma unroll
            for (int b = 0; b < 2; ++b)
#pragma unroll
                for (int m = 0; m < 4; ++m)
#pragma unroll
                    for (int n = 0; n < 2; ++n) acc[a][b][m][n] = (f32x4){0.f, 0.f, 0.f, 0.f};
        cur = nxt; cB = nB; cA00 = nA00; cA01 = nA01; cA10 = nA10; cA11 = nA11; ++ui;
        if (wr == 1) G_BAR;
    }
    G_WAIT_V(0);
    G_BAR;
    if constexpr (Epi::AFTER_DRAIN) { E.fused(acc, cur, wr, wc, fr, fq, lds, wid, lane); }
#undef G_SA
#undef G_SB
#undef G_STAGE
#undef G_LDA
#undef G_LDB
#undef G_MMA
#undef G_WAIT_V
#undef G_WAIT_L
#undef G_BAR
#undef G_SCHED
}
}

constexpr int NXCD = 8, WGM = 8;
struct BrowStd  { static __host__ __device__ __forceinline__ int brow(int R) { return (R & ~31) + gm::perm32(R & 31); } };
struct BrowHead { static __host__ __device__ __forceinline__ int brow(int R) { return 64 * (R >> 5) + gm::perm32(R & 31); } };

template <class BR>
struct DenseSched : BR {
    const char* A; unsigned lda_bytes; const char* Bt; size_t tstepB_, hstepB_, bsplit = 0; int nM, nN, nwg, G, c;
    __device__ __forceinline__ void init(const void* A_, unsigned lda_b, const void* Bt_, size_t tstepB, size_t hstepB, int Mrows, int ntn, int G_, int c_) {
        A = (const char*)A_; lda_bytes = lda_b; Bt = (const char*)Bt_; tstepB_ = tstepB; hstepB_ = hstepB; nM = Mrows / 256; nN = ntn; nwg = nM * nN; G = G_; c = c_; }
    __device__ __forceinline__ bool next(int i, gm::Unit& u) const {
        const long L = (long)i * G + c; if (L >= nwg) return false;
        int wgid = (int)L; { const int q = nwg / NXCD, r = nwg % NXCD, xcd = wgid % NXCD, off = wgid / NXCD; wgid = (xcd < r ? xcd * (q + 1) : r * (q + 1) + (xcd - r) * q) + off; }
        const int nig = WGM * nN, gid = wgid / nig, fm = gid * WGM, gsz = (nM - fm) < WGM ? (nM - fm) : WGM;
        u.pm = fm + ((wgid % nig) % gsz); u.pn = (wgid % nig) / gsz; u.aux = 0; u.cnt = 0; return true;
    }
    __device__ __forceinline__ const char* a_base() const { return A; }
    __device__ __forceinline__ unsigned a_off(const gm::Unit& u, int row) const { return (unsigned)(u.pm * 256 + row) * lda_bytes; }
    __device__ __forceinline__ const char* b_base(const gm::Unit& u) const { return Bt + (size_t)(u.pm >> 6) * bsplit + (size_t)u.pn * tstepB_; }
    __device__ __forceinline__ size_t hstepB() const { return hstepB_; }
};

struct MoeSched : BrowStd {
    const char* A; const int* list; const char* Bt; size_t estride, tstepB_, hstepB_; int npn, G, c, ntot; bool gather;
    const LAS int* tstart; const LAS int* ecnt;
    __device__ __forceinline__ bool next(int i, gm::Unit& u) const {
        if (G == 256) {
            const int x = c >> 5; int L = i * 32 + (c & 31);
#pragma unroll 1
            for (int k = 0; k < 4; ++k) {
                const int e = x + 8 * k, t0 = __builtin_amdgcn_readfirstlane(tstart[e]), nt = __builtin_amdgcn_readfirstlane(tstart[e + 1]) - t0, units = nt * npn;
                if (L < units) { const int quad = nt * 4, pnh = L / quad, r2 = L - pnh * quad, rt = r2 >> 2; u.pn = pnh * 4 + (r2 & 3); u.pm = t0 + rt; u.aux = e; u.cnt = rt * 256; return true; }
                L -= units;
            }
            return false;
        }
        const long L = (long)i * G + c; if (L >= (long)ntot * npn) return false;
        const int rt = (int)(L / npn); u.pn = (int)(L % npn); u.pm = rt;
        int e = 0;
#pragma unroll 1
        for (int k = 1; k < NE; ++k) e = (__builtin_amdgcn_readfirstlane(tstart[k]) <= rt) ? k : e;
        u.aux = e; u.cnt = (rt - __builtin_amdgcn_readfirstlane(tstart[e])) * 256; return true;
    }
    __device__ __forceinline__ const char* a_base() const { return A; }
    __device__ __forceinline__ unsigned a_off(const gm::Unit& u, int row) const {
        if (gather) { const int last = __builtin_amdgcn_readfirstlane(ecnt[u.aux]) - 1; const int pos = min(u.cnt + row, last); return (unsigned)list[u.aux * M + pos] * 1024u; }
        return (unsigned)(u.pm * 256 + row) * 1024u;
    }
    __device__ __forceinline__ const char* b_base(const gm::Unit& u) const { return Bt + (size_t)u.aux * estride + (size_t)u.pn * tstepB_; }
    __device__ __forceinline__ size_t hstepB() const { return hstepB_; }
};

__device__ __forceinline__ size_t kimg_off(int t, int d) { return (size_t)(t >> 6) * 4096 + (d >> 3) * 512 + (t & 63) * 8 + (d & 7); }
__device__ __forceinline__ size_t vimg_off(int t, int d) { return (size_t)(t >> 6) * 4096 + (d >> 5) * 2048 + (t & 63) * 32 + (d & 31); }
__device__ __forceinline__ u32x4 pack8(const f32x4 a, const f32x4 b) { u32x4 w; w.x = pk2(a[0], a[1]); w.y = pk2(a[2], a[3]); w.z = pk2(b[0], b[1]); w.w = pk2(b[2], b[3]); return w; }
__device__ __forceinline__ void st8(bf16_t* p, const f32x4 a, const f32x4 b) { *(u32x4*)p = pack8(a, b); }

struct EpiFoxQKV {
    static constexpr bool AFTER_DRAIN = false;
    bf16_t* Q; const float* gain;
    __device__ __forceinline__ void operator()(const f32x4 (&acc)[2][2][4][2], const gm::Unit& u, int wr, int wc, int fr, int fq) const {
        const int hidx = 4 * u.pn + wc, kind = hidx >> 4, head = hidx & 15;
        bf16_t* base = Q + (size_t)kind * ((size_t)M * D) + head * 64 + 8 * fq;
        f32x4 g[2][2];
#pragma unroll
        for (int bj = 0; bj < 2; ++bj)
#pragma unroll
            for (int n = 0; n < 2; ++n) g[bj][n] = (kind < 2) ? *(const f32x4*)(gain + kind * 64 + 32 * bj + 8 * fq + 4 * n) : (f32x4){1.f, 1.f, 1.f, 1.f};
        const float sc = (kind == 0) ? C2 : 1.f;
#pragma unroll
        for (int ai = 0; ai < 2; ++ai)
#pragma unroll
            for (int m = 0; m < 4; ++m) {
                const int row = u.pm * 256 + ai * 128 + wr * 64 + m * 16 + fr;
                float rs = 1.f;
                if (kind < 2) {
                    float s = 0.f;
#pragma unroll
                    for (int bj = 0; bj < 2; ++bj)
#pragma unroll
                        for (int n = 0; n < 2; ++n) { const f32x4 v = acc[ai][bj][m][n]; s += (v[0] * v[0] + v[1] * v[1]) + (v[2] * v[2] + v[3] * v[3]); }
                    s += __shfl_xor(s, 16); s += __shfl_xor(s, 32);
                    rs = __builtin_amdgcn_rsqf(s * (1.f / 64.f) + EPS) * sc;
                }
                const int bb = row >> 13, tt = row & (T - 1);
                bf16_t* hb = Q + (size_t)kind * ((size_t)M * D) + ((size_t)(bb * NH + head) * T) * HD;
#pragma unroll
                for (int bj = 0; bj < 2; ++bj) { bf16_t* dst = kind == 0 ? base + (size_t)row * D + 32 * bj : hb + (kind == 1 ? kimg_off(tt, 32 * bj + 8 * fq) : vimg_off(tt, 32 * bj + 8 * fq));
                    *(u32x4*)dst = pack8(acc[ai][bj][m][0] * rs * g[bj][0], acc[ai][bj][m][1] * rs * g[bj][1]); }
            }
    }
};

struct EpiNsaKVQ {
    static constexpr bool AFTER_DRAIN = false;
    bf16_t* Q; bf16_t* kv6; const float* kgain; const float* qgain; const float* rope; const float* rstd;
    __device__ __forceinline__ void operator()(const f32x4 (&acc)[2][2][4][2], const gm::Unit& u, int wr, int wc, int fr, int fq) const {
        const int hidx = 4 * u.pn + wc;
        const bool isq = hidx >= 24; const int j = hidx >> 2, g = hidx & 3;
        const bool donorm = isq || j == 2 || j == 4;
        const float* gp = isq ? qgain : (kgain + (j == 2 ? 64 : 128));
        f32x4 gn[2][2];
#pragma unroll
        for (int bj = 0; bj < 2; ++bj)
#pragma unroll
            for (int n = 0; n < 2; ++n) gn[bj][n] = donorm ? *(const f32x4*)(gp + 32 * bj + 8 * fq + 4 * n) : (f32x4){1.f, 1.f, 1.f, 1.f};
        const float sc = isq ? C2 : 1.f;
#pragma unroll
        for (int ai = 0; ai < 2; ++ai)
#pragma unroll
            for (int m = 0; m < 4; ++m) {
                const int row = u.pm * 256 + ai * 128 + wr * 64 + m * 16 + fr; const int b = row >> 13, t = row & (T - 1);
                f32x4 v[2][2]; const float rr_ = rstd[row];
#pragma unroll
                for (int bj = 0; bj < 2; ++bj)
#pragma unroll
                    for (int n = 0; n < 2; ++n) v[bj][n] = acc[ai][bj][m][n] * rr_;
                if (donorm) {
                    float s = 0.f;
#pragma unroll
                    for (int bj = 0; bj < 2; ++bj)
#pragma unroll
                        for (int n = 0; n < 2; ++n) { const f32x4 w = v[bj][n]; s += (w[0] * w[0] + w[1] * w[1]) + (w[2] * w[2] + w[3] * w[3]); }
                    s += __shfl_xor(s, 16); s += __shfl_xor(s, 32);
                    const float rs = __builtin_amdgcn_rsqf(s * (1.f / 64.f) + EPS);
#pragma unroll
                    for (int bj = 0; bj < 2; ++bj)
#pragma unroll
                        for (int n = 0; n < 2; ++n) v[bj][n] = v[bj][n] * rs * gn[bj][n];
#pragma unroll
                    for (int n = 0; n < 2; ++n) {
                        const f32x4 cs0 = *(const f32x4*)(rope + ((size_t)t * 8 + 4 * n) * 2), cs1 = *(const f32x4*)(rope + ((size_t)t * 8 + 4 * n) * 2 + 4);
                        const float cc[4] = {cs0[0], cs0[2], cs1[0], cs1[2]}, ss[4] = {cs0[1], cs0[3], cs1[1], cs1[3]};
#pragma unroll
                        for (int jj = 0; jj < 4; ++jj) {
                            const float own = v[0][n][jj], oth = __shfl_xor(own, 16);
                            const float r0 = own * cc[jj] - oth * ss[jj], r1 = own * cc[jj] + oth * ss[jj];
                            v[0][n][jj] = fq == 0 ? r0 : (fq == 1 ? r1 : own);
                        }
                    }
#pragma unroll
                    for (int bj = 0; bj < 2; ++bj)
#pragma unroll
                        for (int n = 0; n < 2; ++n) v[bj][n] = v[bj][n] * sc;
                }
                bf16_t* hb = kv6 + (size_t)j * (KV6_STRIDE / 2) + ((size_t)(b * NG + g) * T) * HD;
#pragma unroll
                for (int bj = 0; bj < 2; ++bj) { const int d = 32 * bj + 8 * fq;
                    bf16_t* dst = isq ? (Q + (size_t)row * D + (hidx - 24) * 64 + d) : (j < 2 ? hb + (size_t)t * HD + d : ((j & 1) ? hb + vimg_off(t, d) : hb + kimg_off(t, d)));
                    *(u32x4*)dst = pack8(v[bj][0], v[bj][1]); }
            }
    }
};

template <class TB>
struct EpiResid {
    static constexpr bool AFTER_DRAIN = false;
    const TB* base; bf16_t* out;
    __device__ __forceinline__ void operator()(const f32x4 (&acc)[2][2][4][2], const gm::Unit& u, int wr, int wc, int fr, int fq) const {
        const int col0 = u.pn * 256 + wc * 32 + 8 * fq;
#pragma unroll
        for (int ai = 0; ai < 2; ++ai)
#pragma unroll
            for (int m = 0; m < 4; ++m) { const size_t off = (size_t)(u.pm * 256 + ai * 128 + wr * 64 + m * 16 + fr) * D + col0;
#pragma unroll
                for (int bj = 0; bj < 2; ++bj) { f32x4 b0, b1; ld8(base + off + bj * 128, b0, b1);
                    *(u32x4*)(out + off + bj * 128) = pack8(b0 + acc[ai][bj][m][0], b1 + acc[ai][bj][m][1]); } }
    }
};

struct EpiBf16 {
    static constexpr bool AFTER_DRAIN = false;
    bf16_t* O; int ldc;
    __device__ __forceinline__ void operator()(const f32x4 (&acc)[2][2][4][2], const gm::Unit& u, int wr, int wc, int fr, int fq) const {
        const int col0 = u.pn * 256 + wc * 32 + 8 * fq;
#pragma unroll
        for (int ai = 0; ai < 2; ++ai)
#pragma unroll
            for (int m = 0; m < 4; ++m) { bf16_t* rowp = O + (size_t)(u.pm * 256 + ai * 128 + wr * 64 + m * 16 + fr) * ldc + col0;
#pragma unroll
                for (int bj = 0; bj < 2; ++bj) *(u32x4*)(rowp + bj * 128) = pack8(acc[ai][bj][m][0], acc[ai][bj][m][1]); }
    }
};

template <class TO>
struct EpiPle {
    static constexpr bool AFTER_DRAIN = false;
    const bf16_t* xin; TO* out; const bf16_t* pp;
    __device__ __forceinline__ void operator()(const f32x4 (&acc)[2][2][4][2], const gm::Unit& u, int wr, int wc, int fr, int fq) const {
        const int col0 = u.pn * 256 + wc * 32 + 8 * fq;
#pragma unroll
        for (int ai = 0; ai < 2; ++ai)
#pragma unroll
            for (int m = 0; m < 4; ++m) { const size_t off = (size_t)(u.pm * 256 + ai * 128 + wr * 64 + m * 16 + fr) * D + col0;
#pragma unroll
                for (int bj = 0; bj < 2; ++bj) {
                    f32x4 b[2], pv[2], o[2]; ld8(xin + off + bj * 128, b[0], b[1]); ld8(pp + off + bj * 128, pv[0], pv[1]);
#pragma unroll
                    for (int n = 0; n < 2; ++n)
#pragma unroll
                        for (int jj = 0; jj < 4; ++jj) { const float sg = __builtin_amdgcn_rcpf(1.f + __builtin_amdgcn_exp2f(acc[ai][bj][m][n][jj] * (-W8_INV * LOG2E))); o[n][jj] = b[n][jj] + sg * pv[n][jj]; }
                    st8(out + off + bj * 128, o[0], o[1]); } }
    }
};

struct EpiSwiglu {
    static constexpr bool AFTER_DRAIN = false;
    unsigned char* Hb; const float* bgu;
    __device__ __forceinline__ void operator()(const f32x4 (&acc)[2][2][4][2], const gm::Unit& u, int wr, int wc, int fr, int fq) const {
        const int f0 = u.pn * 128 + wc * 32 + 8 * fq; const float* bb = bgu + (size_t)u.aux * 2048 + f0;
        f32x4 ba[2], bu[2];
#pragma unroll
        for (int n = 0; n < 2; ++n) { ba[n] = *(const f32x4*)(bb + 4 * n); bu[n] = *(const f32x4*)(bb + 1024 + 4 * n); }
#pragma unroll
        for (int ai = 0; ai < 2; ++ai)
#pragma unroll
            for (int m = 0; m < 4; ++m) { unsigned char* rowp = Hb + (size_t)(u.pm * 256 + ai * 128 + wr * 64 + m * 16 + fr) * FF + f0;
                f32x4 y[2];
#pragma unroll
                for (int n = 0; n < 2; ++n) { const f32x4 a4 = acc[ai][0][m][n] * W8_INV + ba[n], u4 = acc[ai][1][m][n] * W8_INV + bu[n];
#pragma unroll
                    for (int jj = 0; jj < 4; ++jj) { const float a = fminf(a4[jj], 7.f), uu = fminf(fmaxf(u4[jj], -7.f), 7.f); y[n][jj] = (uu + 1.f) * (a * __builtin_amdgcn_rcpf(1.f + __builtin_amdgcn_exp2f(a * (-1.702f * LOG2E)))); } }
                u32x2 o8; o8.x = pk4_fp8(y[0][0], y[0][1], y[0][2], y[0][3]); o8.y = pk4_fp8(y[1][0], y[1][1], y[1][2], y[1][3]); *(u32x2*)rowp = o8; }
    }
};

struct EpiDown {
    static constexpr bool AFTER_DRAIN = false;
    unsigned char* Y; const float* bdn; const float* gl;
    __device__ __forceinline__ void operator()(const f32x4 (&acc)[2][2][4][2], const gm::Unit& u, int wr, int wc, int fr, int fq) const {
        const int col0 = u.pn * 256 + wc * 32 + 8 * fq; const float* bb = bdn + (size_t)u.aux * D + col0;
        f32x4 bv[2][2];
#pragma unroll
        for (int bj = 0; bj < 2; ++bj)
#pragma unroll
            for (int n = 0; n < 2; ++n) bv[bj][n] = *(const f32x4*)(bb + bj * 128 + 4 * n);
#pragma unroll
        for (int ai = 0; ai < 2; ++ai)
#pragma unroll
            for (int m = 0; m < 4; ++m) { const int r = ai * 128 + wr * 64 + m * 16 + fr; int pos = u.cnt + r; pos = pos < M ? pos : M - 1;
                const float gt = gl[(size_t)u.aux * M + pos];
                unsigned char* rowp = Y + (size_t)(u.pm * 256 + r) * D + col0; const float gy = gt * Y8_SCALE;
#pragma unroll
                for (int bj = 0; bj < 2; ++bj) { const f32x4 y0 = (acc[ai][bj][m][0] * W8_INV + bv[bj][0]) * gy, y1 = (acc[ai][bj][m][1] * W8_INV + bv[bj][1]) * gy;
                    u32x2 o8; o8.x = pk4_fp8(y0[0], y0[1], y0[2], y0[3]); o8.y = pk4_fp8(y1[0], y1[1], y1[2], y1[3]); *(u32x2*)(rowp + bj * 128) = o8; } }
    }
};

struct Frame {
    LAS unsigned char* lds; int tid, lane, wave, G, vcu, gw, NGW, bx; unsigned char* ws;
};
#define WSP(T_, off) ((T_*)(F.ws + (off)))

__device__ __forceinline__ void transpose_item(const float* W, int ldw, const float* gain, bf16_t* WT, int ldwt, LAS float* scr, int k0, int n0, int lane, bool f8) {
    f32x4 v[16]; const int rr = lane >> 4, cc = 4 * (lane & 15);
#pragma unroll
    for (int i = 0; i < 16; ++i) v[i] = __builtin_nontemporal_load((const f32x4*)(W + (size_t)(k0 + 4 * i + rr) * ldw + n0 + cc));
#pragma unroll
    for (int i = 0; i < 16; ++i) { const int kk = 4 * i + rr; const float gk = gain ? gain[k0 + kk] : 1.f; LAS float* d = scr + kk * 65 + cc;
        d[0] = v[i][0] * gk; d[1] = v[i][1] * gk; d[2] = v[i][2] * gk; d[3] = v[i][3] * gk; }
    LDS_WAIT(); asm volatile("" ::: "memory");
    const int c = lane & 7;
    if (f8) {
#pragma unroll
        for (int p = 0; p < 8; ++p) { const int n = 8 * p + (lane >> 3); const LAS float* s = scr + (8 * c) * 65 + n;
            u32x2 o; o.x = pk4_fp8(s[0 * 65] * W8_SCALE, s[1 * 65] * W8_SCALE, s[2 * 65] * W8_SCALE, s[3 * 65] * W8_SCALE); o.y = pk4_fp8(s[4 * 65] * W8_SCALE, s[5 * 65] * W8_SCALE, s[6 * 65] * W8_SCALE, s[7 * 65] * W8_SCALE);
            *(u32x2*)((unsigned char*)WT + (size_t)(n0 + n) * ldwt + k0 + 8 * c) = o; }
        LDS_WAIT(); asm volatile("" ::: "memory");
        return;
    }
#pragma unroll
    for (int p = 0; p < 8; ++p) { const int n = 8 * p + (lane >> 3); const LAS float* s = scr + (8 * c) * 65 + n;
        u32x4 o; o.x = pk2(s[0 * 65], s[1 * 65]); o.y = pk2(s[2 * 65], s[3 * 65]); o.z = pk2(s[4 * 65], s[5 * 65]); o.w = pk2(s[6 * 65], s[7 * 65]);
        *(u32x4*)(WT + (size_t)(n0 + n) * ldwt + k0 + 8 * c) = o; }
    LDS_WAIT(); asm volatile("" ::: "memory");
}
struct TJob { const float* W; int ldw, K, N; const float* gain; bf16_t* WT; size_t wstride, tstride, gstride; int nmat; bool f8; };
__device__ __forceinline__ bool run_tjob(const TJob& J, int& r, LAS float* scr, int lane) {
    const int nkb = J.K / 64, nnb = J.N / 64, per = nkb * nnb, total = per * J.nmat;
    if (r >= total) { r -= total; return false; }
    const int m = r / per, q = r % per, kb = q / nnb, nb = q % nnb;
    const bool f8 = J.f8;
    transpose_item(J.W + (size_t)m * J.wstride, J.ldw, J.gain ? J.gain + (size_t)(m / 32) * J.gstride : nullptr, f8 ? (bf16_t*)((unsigned char*)J.WT + (size_t)m * J.tstride) : J.WT + (size_t)m * J.tstride, J.K, scr, kb * 64, nb * 64, lane, f8);
    return true;
}

__device__ __forceinline__ void phase_prologue(Frame& F, const Params& P) {
    LAS float* scr = (LAS float*)(F.lds + F.wave * 16640);
    constexpr int NITEMS = 16 * 48 + 256 + 16 * 24 + 256 + 256 + 256 + 256 + 2 * 4 * 16 + 2 * 32 * 4 + 2 * 4 * 1 + 32 * 16 * 32 + 32 * 16 * 16;
#define TJ(...) { const TJob J_ = {__VA_ARGS__}; if (run_tjob(J_, r, scr, F.lane)) continue; }
    for (int it = F.gw; it < NITEMS; it += F.NGW) {
        int r = it;
        TJ(P.fox_w_in, FOXN, 1024, 3072, P.attn_norm, WSP(bf16_t, WS_WFOXIN), 0, 0, 0, 1, false)
        TJ(P.fox_w_out, 1024, 1024, 1024, nullptr, WSP(bf16_t, WS_WFOXOUT), 0, 0, 0, 1, false)
        TJ(P.kv_w, KVN, 1024, KVN, P.kv_norm, WSP(bf16_t, WS_WNSA), 0, 0, 0, 1, false)
        TJ(P.nsa_w_in, NSAN, 1024, 1024, P.attn_norm + D, WSP(bf16_t, WS_WNSA) + (size_t)KVN * 1024, 0, 0, 0, 1, false)
        TJ(P.nsa_w_out, 1024, 1024, 1024, nullptr, WSP(bf16_t, WS_WNSAOUT), 0, 0, 0, 1, false)
        TJ(P.ple_gate_w, 1024, 1024, 1024, P.ple_norm, WSP(bf16_t, WS_WPLEG), 0, 0, 0, 1, true)
        TJ(P.ple_gate_w + (size_t)D * D, 1024, 1024, 1024, P.ple_norm + D, (bf16_t*)(WSP(unsigned char, WS_WPLEG) + (size_t)D * D), 0, 0, 0, 1, true)
        TJ(P.ple_proj_w, 1024, 256, 1024, nullptr, WSP(bf16_t, WS_WPLEP), (size_t)PLE * D, (size_t)PLE * D, 0, 2, false)
        TJ(P.cmp_w1, 256, 2048, 256, nullptr, WSP(bf16_t, WS_WC1), (size_t)2048 * 256, (size_t)2048 * 256, 0, 2, false)
        TJ(P.cmp_w2, 64, 256, 64, nullptr, WSP(bf16_t, WS_WC2), (size_t)256 * 64, (size_t)256 * 64, 0, 2, false)
        TJ(P.w_gu, 2048, 1024, 2048, P.ffn_norm, WSP(bf16_t, WS_WGU), (size_t)1024 * 2048, (size_t)1024 * 2048, (size_t)D, 32, true)
        TJ(P.w_down, 1024, 1024, 1024, nullptr, WSP(bf16_t, WS_WDN), (size_t)1024 * 1024, (size_t)1024 * 1024, 0, 32, true)
    }
#undef TJ
    const int gt = F.vcu * NTHREADS + F.tid, NGT = F.G * NTHREADS;
    float* rope = WSP(float, WS_ROPE);
    for (int i = gt; i < T * 8; i += NGT) { const int t = i >> 3, c = i & 7; const double inv = pow(500000.0, -(double)c / 8.0), ang = (double)t * inv; rope[2 * i] = (float)cos(ang); rope[2 * i + 1] = (float)sin(ang); }
    float* wft = WSP(float, WS_WFT);
    for (int i = gt; i < 32 * 1024; i += NGT) { const int h = i >> 10, k = i & 1023; wft[i] = h < 16 ? P.attn_norm[k] * P.fox_w_in[(size_t)k * FOXN + 3072 + h] : 0.f; }
    float* wrt = WSP(float, WS_WRT);
    for (int i = gt; i < 2 * 32 * 1024; i += NGT) { const int l = i >> 15, e = (i >> 10) & 31, k = i & 1023; wrt[i] = P.ffn_norm[l * D + k] * P.router_w[((size_t)l * D + k) * NE + e]; }
    float* wgt = WSP(float, WS_WGT);
    for (int i = gt; i < 64 * 1024; i += NGT) { const int c = i >> 10, k = i & 1023; wgt[i] = c < 48 ? P.attn_norm[D + k] * P.nsa_w_in[(size_t)k * NSAN + 1024 + c] : 0.f; }
    { const f32x4* src = (const f32x4*)P.p; u32x2* dst = WSP(u32x2, WS_PBF);
      for (int i = gt; i < 2 * M * PLE / 4; i += NGT) { const f32x4 v = src[i]; u32x2 o; o.x = pk2(v[0], v[1]); o.y = pk2(v[2], v[3]); dst[i] = o; } }
    { float* part = WSP(float, WS_H);
      for (int task = F.gw; task < 2 * 4 * 32; task += F.NGW) { const int j = task >> 7, cg = (task >> 5) & 3, mc = task & 31; const int c = cg * 64 + F.lane;
        const float* w = P.cmp_w1 + ((size_t)j * 2048 + mc * 64) * 256 + c; const float* pp = P.cmp_pos + j * 2048 + mc * 64; float s = 0.f;
#pragma unroll 8
        for (int m = 0; m < 64; ++m) s += pp[m] * w[(size_t)m * 256];
        part[(j * 32 + mc) * 256 + c] = s; } }
}

constexpr int L1_ITEMS = 32 * 16 * 32 + 32 * 16 * 16, L1_SPLIT = 5632;
__device__ __forceinline__ void convert_moe_l1(Frame& F, const Params& P, int worker, int nworkers, int it_lo, int it_hi) {
    LAS float* scr = (LAS float*)(F.lds + F.wave * 16640);
    const int w = worker * NWAVES + F.wave, NW = nworkers * NWAVES;
#define TJ(...) { const TJob J_ = {__VA_ARGS__}; if (run_tjob(J_, r, scr, F.lane)) continue; }
    for (int it = it_lo + w; it < it_hi; it += NW) {
        int r = it;
        TJ(P.w_gu + (size_t)32 * 1024 * 2048, 2048, 1024, 2048, P.ffn_norm + D, (bf16_t*)(WSP(unsigned char, WS_WGU) + (size_t)32 * 1024 * 2048), (size_t)1024 * 2048, (size_t)1024 * 2048, 0, 32, true)
        TJ(P.w_down + (size_t)32 * 1024 * 1024, 1024, 1024, 1024, nullptr, (bf16_t*)(WSP(unsigned char, WS_WDN) + (size_t)32 * 1024 * 1024), (size_t)1024 * 1024, (size_t)1024 * 1024, 0, 32, true)
    }
#undef TJ
}

template <class TX>
__device__ __forceinline__ void row_load(const TX* xrow, int lane, f32x4 (&v)[4]) {
#pragma unroll
    for (int j = 0; j < 4; ++j) v[j] = ld4(xrow + 4 * lane + 256 * j);
}
__device__ __forceinline__ float row_rstd(const f32x4 (&v)[4]) {
    float s = 0.f;
#pragma unroll
    for (int j = 0; j < 4; ++j) s += (v[j][0] * v[j][0] + v[j][1] * v[j][1]) + (v[j][2] * v[j][2] + v[j][3] * v[j][3]);
    return __builtin_amdgcn_rsqf(wave_sum(s) * (1.f / D) + EPS);
}
__device__ __forceinline__ void row_store_bf16(bf16_t* orow, int lane, const f32x4 (&v)[4]) {
    u32x2* o8 = (u32x2*)orow + lane;
#pragma unroll
    for (int j = 0; j < 4; ++j) { u32x2 o; o.x = pk2(v[j][0], v[j][1]); o.y = pk2(v[j][2], v[j][3]); o8[64 * j] = o; }
}
__device__ __forceinline__ float row_dot(const f32x4 (&v)[4], const float* w, int lane) {
    const f32x4* wr = (const f32x4*)w + lane; float s = 0.f;
#pragma unroll
    for (int j = 0; j < 4; ++j) { const f32x4 a = wr[64 * j]; s += (v[j][0] * a[0] + v[j][1] * a[1]) + (v[j][2] * a[2] + v[j][3] * a[3]); }
    return s;
}
__device__ __forceinline__ float reduce16(float (&p)[16], int lane) {
#pragma unroll
    for (int i = 0; i < 8; ++i) { const bool up = lane & 32; const float send = up ? p[i] : p[i + 8], keep = up ? p[i + 8] : p[i]; p[i] = keep + __shfl_xor(send, 32); }
#pragma unroll
    for (int i = 0; i < 4; ++i) { const bool up = lane & 16; const float send = up ? p[i] : p[i + 4], keep = up ? p[i + 4] : p[i]; p[i] = keep + __shfl_xor(send, 16); }
#pragma unroll
    for (int i = 0; i < 2; ++i) { const bool up = lane & 8; const float send = up ? p[i] : p[i + 2], keep = up ? p[i + 2] : p[i]; p[i] = keep + __shfl_xor(send, 8); }
    { const bool up = lane & 4; const float send = up ? p[0] : p[1], keep = up ? p[1] : p[0]; p[0] = keep + __shfl_xor(send, 4); }
    p[0] += __shfl_xor(p[0], 2); p[0] += __shfl_xor(p[0], 1);
    return p[0];
}

template <int NT, bool Q8 = false, class TX, class Post>
__device__ __forceinline__ void rowblock_phase(Frame& F, const TX* xsrc, const float* WT, bf16_t* xn, Post post) {
    constexpr int RS = NT * 32 + 1;
    const int lane = F.lane, wid = F.wave, task = wid >> 2, q = wid & 3, i = lane & 31, kh = lane >> 5;
    LAS float* PART = (LAS float*)F.lds;
    LAS float* SSQ = PART + 2 * 4 * 32 * RS;
    LAS float* RSTD = SSQ + 2 * 4 * 2 * 32;
    for (int blk = F.vcu; blk < M / 64; blk += F.G) {
        const int r0 = blk * 64 + task * 32;
        f32x16 acc[NT];
#pragma unroll
        for (int t = 0; t < NT; ++t) acc[t] = splat16z();
        float ssq = 0.f;
        const TX* xr = xsrc + (size_t)(r0 + i) * D + 256 * q + 8 * kh;
        const float* wr = WT + (size_t)i * D + 256 * q + 8 * kh;
#pragma unroll 2
        for (int s = 0; s < 16; ++s) {
            f32x4 a0, a1; ld8(xr + 16 * s, a0, a1);
            ssq += ((a0[0] * a0[0] + a0[1] * a0[1]) + (a0[2] * a0[2] + a0[3] * a0[3])) + ((a1[0] * a1[0] + a1[1] * a1[1]) + (a1[2] * a1[2] + a1[3] * a1[3]));
#pragma unroll
            for (int t = 0; t < NT; ++t) { const f32x4 b0 = *(const f32x4*)(wr + (size_t)t * 32 * D + 16 * s), b1 = *(const f32x4*)(wr + (size_t)t * 32 * D + 16 * s + 4);
#pragma unroll
                for (int q4 = 0; q4 < 4; ++q4) acc[t] = __builtin_amdgcn_mfma_f32_32x32x2f32(a0[q4], b0[q4], acc[t], 0, 0, 0);
#pragma unroll
                for (int q4 = 0; q4 < 4; ++q4) acc[t] = __builtin_amdgcn_mfma_f32_32x32x2f32(a1[q4], b1[q4], acc[t], 0, 0, 0); }
        }
        LAS float* pp = PART + ((task * 4 + q) * 32) * RS;
#pragma unroll
        for (int t = 0; t < NT; ++t)
#pragma unroll
            for (int r = 0; r < 16; ++r) pp[((r & 3) + 8 * (r >> 2) + 4 * kh) * RS + 32 * t + i] = acc[t][r];
        SSQ[((task * 4 + q) * 2 + kh) * 32 + i] = ssq;
        __syncthreads();
        if (q == 0 && lane < 32) {
            float sq = 0.f;
#pragma unroll
            for (int k = 0; k < 8; ++k) sq += SSQ[(task * 8 + k) * 32 + i];
            const float rstd = __builtin_amdgcn_rsqf(sq * (1.f / D) + EPS);
            RSTD[task * 32 + i] = rstd;
            const LAS float* p0 = PART + ((task * 4) * 32 + i) * RS;
            post(r0 + i, rstd, [&](int c) { return (p0[c] + p0[32 * RS + c]) + (p0[64 * RS + c] + p0[96 * RS + c]); });
        }
        __syncthreads();
        if (xn != nullptr)
#pragma unroll 2
        for (int rr = 0; rr < 8; ++rr) {
            const int row = r0 + 8 * q + rr; const float rstd = RSTD[task * 32 + 8 * q + rr];
            f32x4 v[4]; row_load(xsrc + (size_t)row * D, lane, v);
#pragma unroll
            for (int j = 0; j < 4; ++j) v[j] = v[j] * rstd;
            if constexpr (Q8) { unsigned* o4 = (unsigned*)((unsigned char*)xn + (size_t)row * D) + lane;
#pragma unroll
                for (int j = 0; j < 4; ++j) o4[64 * j] = pk4_fp8(v[j][0], v[j][1], v[j][2], v[j][3]); }
            else row_store_bf16(xn + (size_t)row * D, lane, v);
        }
        __syncthreads();
    }
}

__device__ __forceinline__ void phase_fox_pre(Frame& F, const Params& P) {
    if (F.vcu == 0) { const float* part = WSP(float, WS_H); float* cb1 = WSP(float, WS_CB1); const int i = F.tid; const int j = i >> 8, c = i & 255; float s = 0.f;
        for (int mc = 0; mc < 32; ++mc) s += part[(j * 32 + mc) * 256 + c];
        cb1[i] = s; }
    float* logf = WSP(float, WS_LOGF); const float* bf = P.fox_b_f;
    rowblock_phase<1>(F, P.x, WSP(float, WS_WFT), WSP(bf16_t, WS_XN), [&](int row, float rstd, auto get) {
        const size_t base = (size_t)(row >> 13) * NH * T + (row & (T - 1));
#pragma unroll
        for (int h = 0; h < 16; ++h) { const float z = rstd * get(h) + bf[h]; logf[base + (size_t)h * T] = fminf(z, 0.f) - log1pf(__expf(-fabsf(z))); }
    });
}

__device__ __forceinline__ void fox_scan(Frame& F, int bh) {
    const float* lf = WSP(float, WS_LOGF) + (size_t)bh * T; float* bias = WSP(float, WS_BIAS) + (size_t)bh * T; u32x4* kaug = WSP(u32x4, WS_KAUG) + (size_t)bh * T;
    LAS float* sc = (LAS float*)(F.lds);
    float v[16]; float run = 0.f;
    const f32x4* src = (const f32x4*)(lf + F.tid * 16);
#pragma unroll
    for (int i = 0; i < 4; ++i) { const f32x4 a = src[i]; v[4 * i] = a[0]; v[4 * i + 1] = a[1]; v[4 * i + 2] = a[2]; v[4 * i + 3] = a[3]; }
#pragma unroll
    for (int i = 0; i < 16; ++i) { run += v[i]; v[i] = run; }
    const float incl = wave_scan_f(run);
    if (F.lane == 63) sc[F.wave] = incl;
    __syncthreads();
    float woff = 0.f;
    for (int w = 0; w < F.wave; ++w) woff += sc[w];
    const float base = woff + incl - run;
#pragma unroll
    for (int i = 0; i < 16; ++i) {
        const float bv = -(base + v[i]) * LOG2E;
        const unsigned b0 = f2bf(bv); const float r1 = bv - __builtin_bit_cast(float, b0 << 16);
        const unsigned b1 = f2bf(r1); const float r2 = r1 - __builtin_bit_cast(float, b1 << 16);
        const unsigned b2 = f2bf(r2);
        bias[F.tid * 16 + i] = bv;
        u32x4 o; o.x = b0 | (b1 << 16); o.y = b2 | 0x3F800000u; o.z = 0x3F803F80u; o.w = 0u; kaug[F.tid * 16 + i] = o;
    }
    __syncthreads();
}

__device__ __forceinline__ void phase_moe_route(Frame& F, const Params& P, int layer, const bf16_t* xsrc, int cbank = -1) {
    unsigned* cnt = WSP(unsigned, WS_CTL) + CW_CNT + (cbank < 0 ? layer : cbank) * NE * CNT_STRIDE; int* list = WSP(int, WS_LIST); float* gl = WSP(float, WS_GL); int* tokinfo = WSP(int, WS_TOKINFO);
    const float* rb = P.router_b + layer * NE;
    rowblock_phase<1, true>(F, xsrc, WSP(float, WS_WRT) + (size_t)layer * NE * D, WSP(bf16_t, WS_XN8), [&](int row, float rstd, auto get) {
        float v[NE];
#pragma unroll
        for (int e = 0; e < NE; ++e) v[e] = rstd * get(e) + rb[e];
        float tv[4]; int te[4];
#pragma unroll
        for (int k = 0; k < 4; ++k) {
            float best = -INFINITY; int bi = 0;
#pragma unroll
            for (int e = 0; e < NE; ++e) { const bool tk = v[e] > best; best = tk ? v[e] : best; bi = tk ? e : bi; }
            tv[k] = best; te[k] = bi;
#pragma unroll
            for (int e = 0; e < NE; ++e) v[e] = (e == bi) ? -INFINITY : v[e];
        }
        const float e1 = __expf(tv[1] - tv[0]), e2 = __expf(tv[2] - tv[0]), e3 = __expf(tv[3] - tv[0]);
        const float inv = 1.f / (1.f + e1 + e2 + e3);
        const float gk[4] = {inv, e1 * inv, e2 * inv, e3 * inv};
        LAS unsigned* hist = (LAS unsigned*)(F.lds + LDS_MISC + 640) + (F.wave >> 2) * 64;
        const int li = F.lane;
        hist[li] = 0u; LDS_WAIT(); asm volatile("" ::: "memory");
        unsigned rk[4];
#pragma unroll
        for (int k = 0; k < 4; ++k) rk[k] = __hip_atomic_fetch_add(hist + te[k], 1u, __ATOMIC_RELAXED, __HIP_MEMORY_SCOPE_WORKGROUP);
        LDS_WAIT(); asm volatile("" ::: "memory");
        { const unsigned c = hist[li]; unsigned base = 0u; if (c) base = atomicAdd(cnt + li * CNT_STRIDE, c); hist[32 + li] = base; }
        LDS_WAIT(); asm volatile("" ::: "memory");
#pragma unroll
        for (int k = 0; k < 4; ++k) {
            const int e = te[k]; const unsigned pos = hist[32 + e] + rk[k];
            list[(size_t)e * M + pos] = row; gl[(size_t)e * M + pos] = gk[k]; tokinfo[row * 4 + k] = (e << 16) | (int)pos;
        }
    });
}

__device__ __forceinline__ int moe_tables(Frame& F, int layer, LAS int* tstart, LAS int* ecnt, bool reuse = false) {
    if (N_LAUNCH_MODE == 1 && reuse) return __builtin_amdgcn_readfirstlane(tstart[NE]);
    const unsigned* cnt = WSP(unsigned, WS_CTL) + CW_CNT + layer * NE * CNT_STRIDE;
    if (F.wave == 0) {
        const int e = F.lane; int c = 0;
        if (e < NE) c = (int)__hip_atomic_load(cnt + e * CNT_STRIDE, __ATOMIC_RELAXED, __HIP_MEMORY_SCOPE_AGENT);
        const int tl = (c + 255) >> 8;
        const int incl = (int)wave_scan_f((float)tl);
        if (e < NE) { ecnt[e] = c; tstart[e] = incl - tl; }
        if (e == NE - 1) tstart[NE] = incl;
    }
    __syncthreads();
    return __builtin_amdgcn_readfirstlane(tstart[NE]);
}

__device__ __forceinline__ void phase_moe_combine(Frame& F, int layer, const bf16_t* xsrc) {
    LAS int* tstart = (LAS int*)(F.lds + LDS_MISC); LAS int* ecnt = tstart + 64;
    moe_tables(F, layer, tstart, ecnt, true);
    const int* tokinfo = WSP(int, WS_TOKINFO); const unsigned char* Y = WSP(unsigned char, WS_Y); bf16_t* xb = WSP(bf16_t, WS_XB);
    i32x4 tin = *(const i32x4*)(tokinfo + (F.gw < M ? F.gw : 0) * 4);
    for (int row = F.gw; row < M; row += F.NGW) {
        const i32x4 ti4 = tin;
        { const int rn = row + F.NGW; tin = *(const i32x4*)(tokinfo + (rn < M ? rn : row) * 4); }
        f32x4 v[4]; row_load(xsrc + (size_t)row * D, F.lane, v);
#pragma unroll
        for (int k = 0; k < 4; ++k) {
            const int ti = ti4[k]; const int e = ti >> 16, pos = ti & 0xffff; const size_t slot = (size_t)tstart[e] * 256 + pos;
            const unsigned* yr = (const unsigned*)(Y + slot * D) + F.lane;
#pragma unroll
            for (int j = 0; j < 4; ++j) { const int w = (int)yr[64 * j]; const f32x2 lo = __builtin_amdgcn_cvt_pk_f32_fp8(w, false), hi2 = __builtin_amdgcn_cvt_pk_f32_fp8(w, true);
                v[j][0] += lo[0] * Y8_INV; v[j][1] += lo[1] * Y8_INV; v[j][2] += hi2[0] * Y8_INV; v[j][3] += hi2[1] * Y8_INV; }
        }
#pragma unroll
        for (int j = 0; j < 4; ++j) st4(xb + (size_t)row * D + 4 * F.lane + 256 * j, v[j]);
        const float rs = row_rstd(v);
#pragma unroll
        for (int j = 0; j < 4; ++j) v[j] = v[j] * rs;
        { unsigned* o4 = (unsigned*)(WSP(unsigned char, WS_XN8) + (size_t)row * D) + F.lane;
#pragma unroll
          for (int j = 0; j < 4; ++j) o4[64 * j] = pk4_fp8(v[j][0], v[j][1], v[j][2], v[j][3]); }
    }
}

__device__ __forceinline__ void phase_nsa_pre(Frame& F) {
    float* gates = WSP(float, WS_GATES);
    float* rstd_out = WSP(float, WS_RSTD);
    rowblock_phase<2>(F, WSP(bf16_t, WS_XB), WSP(float, WS_WGT), (bf16_t*)nullptr, [&](int row, float rstd, auto get) {
        rstd_out[row] = rstd;
#pragma unroll
        for (int c4 = 0; c4 < 12; ++c4) { f32x4 o;
#pragma unroll
            for (int jj = 0; jj < 4; ++jj) o[jj] = __builtin_amdgcn_rcpf(1.f + __builtin_amdgcn_exp2f((-LOG2E * rstd) * get(4 * c4 + jj)));
            *(f32x4*)(gates + (size_t)row * 48 + 4 * c4) = o; }
    });
}

constexpr int AT_K0 = 0  , AT_V0 = 16384  , AT_OST = 0  , AT_WSF = 40960, AT_IMP = 43008, AT_SELM = 75776, AT_OT = 76800, AT_END = AT_OT + 65536;
static_assert(AT_END <= LDS_MISC, "attention LDS map vs control words");
static_assert(AT_END <= LDS_BYTES, "attention LDS map");
__device__ __forceinline__ int crow(int r, int hi) { return (r & 3) + 8 * (r >> 2) + 4 * hi; }
__device__ __forceinline__ unsigned cvtpk(float lo, float hi) { f32x2 v = {lo, hi}; bf16x2_t b = __builtin_convertvector(v, bf16x2_t); return __builtin_bit_cast(unsigned, b); }
typedef short v4i16_t __attribute__((ext_vector_type(4)));
__device__ __forceinline__ s16x4 vtr(const LAS char* p) { return __builtin_bit_cast(s16x4, __builtin_amdgcn_ds_read_tr16_b64_v4i16((LAS v4i16_t*)p)); }

__device__ __forceinline__ void glds16(const void* gsrc, unsigned lds_dst) { unsigned keep;
    asm volatile("s_mov_b32 %0, m0\n\ts_mov_b32 m0, %2\n\ts_nop 0\n\tglobal_load_lds_dwordx4 %1, off\n\ts_mov_b32 m0, %0" : "=&s"(keep) : "v"(gsrc), "s"(lds_dst) : "memory"); }
#define WAIT_BAR0() asm volatile("s_waitcnt vmcnt(0) lgkmcnt(0)\n\ts_barrier" ::: "memory")
__device__ __forceinline__ void tile_dma(const bf16_t* Kt, const bf16_t* Vt, LAS unsigned char* lds, int buf, int tid, int wave) {
    const unsigned base = (unsigned)(uintptr_t)lds + (unsigned)wave * 1024u + (unsigned)buf * 8192u;
    glds16(Kt + tid * 8, (unsigned)__builtin_amdgcn_readfirstlane((int)(base + AT_K0)));
    glds16(Vt + tid * 8, (unsigned)__builtin_amdgcn_readfirstlane((int)(base + AT_V0)));
}
struct TileRegs { u32x4 k, v; };
__device__ __forceinline__ void tile_load(TileRegs& r, const bf16_t* Kt, const bf16_t* Vt, int stride, int tid) {
    (void)stride;
    r.k = *(const u32x4*)(Kt + tid * 8);
    r.v = *(const u32x4*)(Vt + tid * 8);
}
__device__ __forceinline__ void tile_store(const TileRegs& r, LAS unsigned char* lds, int buf, int tid) {
    *(LAS u32x4*)(lds + AT_K0 + buf * 8192 + tid * 16) = r.k;
    *(LAS u32x4*)(lds + AT_V0 + buf * 8192 + tid * 16) = r.v;
}
__device__ __forceinline__ void qk_tile(f32x16& p0, f32x16& p1, const LAS unsigned char* Kbuf, const bf16x8 (&qr)[4], int r32, int hi) {
    const f32x16 cinit = {0.f, 0.f, 0.f, 0.f, 0.f, 0.f, 0.f, 0.f, 0.f, 0.f, 0.f, 0.f, 0.f, 0.f, 0.f, 0.f};
    const LAS unsigned char* kb = Kbuf + hi * 1024 + r32 * 16;
    bf16x8 kf[8];
#pragma unroll
    for (int d0 = 0; d0 < 4; ++d0) { kf[d0] = *(const LAS bf16x8*)(kb + d0 * 2048); kf[4 + d0] = *(const LAS bf16x8*)(kb + d0 * 2048 + 512); }
    __builtin_amdgcn_sched_barrier(0);
#pragma unroll
    for (int d0 = 0; d0 < 4; ++d0) p0 = __builtin_amdgcn_mfma_f32_32x32x16_bf16(kf[d0], qr[d0], d0 ? p0 : cinit, 0, 0, 0);
#pragma unroll
    for (int d0 = 0; d0 < 4; ++d0) p1 = __builtin_amdgcn_mfma_f32_32x32x16_bf16(kf[4 + d0], qr[d0], d0 ? p1 : cinit, 0, 0, 0);
}
struct VFrag { s16x4 lo[2][4], hh[2][4]; };
__device__ __forceinline__ void v_load(VFrag& vf, const LAS unsigned char* Vbuf, int lane) {
    const int hi = lane >> 5;
    const LAS char* vp = (const LAS char*)Vbuf + ((lane >> 4) & 1) * 32 + (lane & 3) * 8 + (4 * hi + ((lane & 15) >> 2)) * 64;
#pragma unroll
    for (int d0 = 0; d0 < 2; ++d0)
#pragma unroll
        for (int ks = 0; ks < 4; ++ks) { vf.lo[d0][ks] = vtr(vp + d0 * 4096 + ks * 1024); vf.hh[d0][ks] = vtr(vp + d0 * 4096 + ks * 1024 + 512); }
    __builtin_amdgcn_sched_barrier(0);
}
__device__ __forceinline__ void pv_tile(f32x16 (&o)[2], const VFrag& vf, const f32x16& p0, const f32x16& p1) {
    u32x4 pw[4];
#pragma unroll
    for (int i = 0; i < 4; ++i) { pw[0][i] = cvtpk(p0[2 * i], p0[2 * i + 1]); pw[1][i] = cvtpk(p0[8 + 2 * i], p0[9 + 2 * i]); pw[2][i] = cvtpk(p1[2 * i], p1[2 * i + 1]); pw[3][i] = cvtpk(p1[8 + 2 * i], p1[9 + 2 * i]); }
#pragma unroll
    for (int d0 = 0; d0 < 2; ++d0)
#pragma unroll
        for (int ks = 0; ks < 4; ++ks) {
            const bf16x8 v8 = (bf16x8){vf.lo[d0][ks][0], vf.lo[d0][ks][1], vf.lo[d0][ks][2], vf.lo[d0][ks][3], vf.hh[d0][ks][0], vf.hh[d0][ks][1], vf.hh[d0][ks][2], vf.hh[d0][ks][3]};
            o[d0] = __builtin_amdgcn_mfma_f32_32x32x16_bf16(__builtin_bit_cast(bf16x8, pw[ks]), v8, o[d0], 0, 0, 0);
        }
}
__device__ __forceinline__ float half_swap_add(float v) { return xor32_sum(v); }
__device__ __forceinline__ f32x16 splat16(float v) { f32x16 r;
#pragma unroll
    for (int i = 0; i < 16; ++i) r[i] = v; return r; }
__device__ __forceinline__ float psum(const f32x16& p0, const f32x16& p1) { float s = 0.f;
#pragma unroll
    for (int r = 0; r < 16; ++r) s += p0[r] + p1[r]; return s; }

template <class RowPtr>
__device__ __forceinline__ void store_o(const f32x16 (&o)[2], LAS unsigned char* lds, int wid, int lane, RowPtr rowptr) {
    const int r32 = lane & 31, hi = lane >> 5;
    LAS bf16_t* stg = (LAS bf16_t*)(lds + AT_OST) + wid * 2048;
#pragma unroll
    for (int r = 0; r < 16; ++r) { const int orow = crow(r, hi);
#pragma unroll
        for (int d0 = 0; d0 < 2; ++d0) stg[orow * 64 + d0 * 32 + r32] = (bf16_t)f2bf(o[d0][r]); }
    LDS_WAIT();
#pragma unroll
    for (int i = 0; i < 4; ++i) { const int row = i * 8 + (lane >> 3), ch = lane & 7; const u32x4 v = *(const LAS u32x4*)(stg + row * 64 + ch * 8); *(u32x4*)(rowptr(row) + ch * 8) = v; }
    LDS_WAIT();
}
__device__ __forceinline__ void row_factors(float f, float (&fr)[16], LAS unsigned char* lds, int wid, int lane) {
    LAS float* wsf = (LAS float*)(lds + AT_WSF) + wid * 64; const int r32 = lane & 31, hi = lane >> 5;
    if (hi == 0) wsf[r32] = f;
    LDS_WAIT();
#pragma unroll
    for (int r = 0; r < 16; ++r) fr[r] = wsf[crow(r, hi)];
    LDS_WAIT();
}
__device__ __forceinline__ float gain_bound(const float* ga, const float* gb, int lane) {
    const float a = wave_max(fabsf(ga[lane])), b = wave_max(fabsf(gb[lane]));
    return 8.f * a * b * LOG2E * 1.03f + 0.05f;
}

__device__ __forceinline__ void fox_unit(Frame& F, const Params& P, int b, int h, int qb, float qbound) {
    const int tid = F.tid, lane = F.lane, wid = F.wave, r32 = lane & 31, hi = lane >> 5;
    const bf16_t* Q = WSP(bf16_t, WS_Q); const bf16_t* Kb = WSP(bf16_t, WS_K); const bf16_t* Vb = WSP(bf16_t, WS_V); bf16_t* O = WSP(bf16_t, WS_O);
    const float* bias = WSP(float, WS_BIAS) + (size_t)(b * NH + h) * T; const u32x4* kaug = WSP(u32x4, WS_KAUG) + (size_t)(b * NH + h) * T;
    const size_t rowbase = (size_t)b * T; const int q0 = qb * 256; const int t = q0 + wid * 32 + r32;
    bf16x8 qr[4];
#pragma unroll
    for (int d0 = 0; d0 < 4; ++d0) qr[d0] = *(const bf16x8*)(Q + (rowbase + t) * D + h * 64 + d0 * 16 + hi * 8);
    bf16x8 qa = (bf16x8){0, 0, 0, 0, 0, 0, 0, 0};
    if (hi == 0) { const float cv = -(bias[t] + qbound); const unsigned c0 = f2bf(cv); const float r1 = cv - __builtin_bit_cast(float, c0 << 16); const unsigned c1 = f2bf(r1); const float r2 = r1 - __builtin_bit_cast(float, c1 << 16); const unsigned c2 = f2bf(r2);
        qa = (bf16x8){0x3F80, 0x3F80, 0x3F80, (short)c0, (short)c1, (short)c2, 0, 0}; }
    f32x16 o[2]; o[0] = splat16(0.f); o[1] = splat16(0.f); float l = 0.f;
    const int NT = 4 * qb + 4;
    int jmin;
    { const float thr = 2.f * qbound + 44.f, bq = bias[q0];
      const bool c0 = (lane < NT) && (bq - bias[64 * lane + 63] <= thr), c1 = (lane + 64 < NT) && (bq - bias[64 * (lane + 64) + 63] <= thr);
      const unsigned long long m0 = __ballot(c0), m1 = __ballot(c1);
      jmin = m0 ? (__ffsll((long long)m0) - 1) : (64 + __ffsll((long long)m1) - 1); }
    const int ntile = NT - jmin;
    int jmin_w;
    { const float thr = 2.f * qbound + 44.f, bq = bias[q0 + wid * 32];
      const bool c0 = (lane < NT) && (bq - bias[64 * lane + 63] <= thr), c1 = (lane + 64 < NT) && (bq - bias[64 * (lane + 64) + 63] <= thr);
      const unsigned long long m0 = __ballot(c0), m1 = __ballot(c1);
      jmin_w = m0 ? (__ffsll((long long)m0) - 1) : (m1 ? (64 + __ffsll((long long)m1) - 1) : NT); }
    const bf16_t* Kh = Kb + ((size_t)(b * NH + h) * T) * HD; const bf16_t* Vh = Vb + ((size_t)(b * NH + h) * T) * HD;
    tile_dma(Kh + (size_t)(NT - 1) * 4096, Vh + (size_t)(NT - 1) * 4096, F.lds, 0, tid, wid);
    u32x4 kan0 = kaug[(NT - 1) * 64 + r32], kan1 = kaug[(NT - 1) * 64 + 32 + r32];
    WAIT_BAR0();
    for (int jj = 0; jj < ntile; ++jj) {
        const int j = NT - 1 - jj;
        const u32x4 ka0 = kan0, ka1 = kan1;
        if (jj + 1 < ntile) { tile_dma(Kh + (size_t)(j - 1) * 4096, Vh + (size_t)(j - 1) * 4096, F.lds, (jj + 1) & 1, tid, wid); kan0 = kaug[(j - 1) * 64 + r32]; kan1 = kaug[(j - 1) * 64 + 32 + r32]; }
        const LAS unsigned char* Kbuf = F.lds + AT_K0 + (jj & 1) * 8192; const LAS unsigned char* Vbuf = F.lds + AT_V0 + (jj & 1) * 8192;
        if (j * 64 <= q0 + wid * 32 + 31 && j >= jmin_w) {
        f32x16 p0, p1; qk_tile(p0, p1, Kbuf, qr, r32, hi);
        p0 = __builtin_amdgcn_mfma_f32_32x32x16_bf16(__builtin_bit_cast(bf16x8, ka0), qa, p0, 0, 0, 0);
        p1 = __builtin_amdgcn_mfma_f32_32x32x16_bf16(__builtin_bit_cast(bf16x8, ka1), qa, p1, 0, 0, 0);
        VFrag vf; v_load(vf, Vbuf, lane);
        const bool band = j >= 4 * qb;
        if (band) {
#pragma unroll
            for (int r = 0; r < 16; ++r) {
                const int kv = j * 64 + crow(r, hi);
                const float e0 = __builtin_amdgcn_exp2f(p0[r]), e1 = __builtin_amdgcn_exp2f(p1[r]);
                p0[r] = kv > t ? 0.f : e0; p1[r] = kv + 32 > t ? 0.f : e1;
            }
        } else {
#pragma unroll
            for (int r = 0; r < 16; ++r) { p0[r] = __builtin_amdgcn_exp2f(p0[r]); p1[r] = __builtin_amdgcn_exp2f(p1[r]); }
        }
        l += psum(p0, p1);
        pv_tile(o, vf, p0, p1);
        }
        WAIT_BAR0();
    }
    l = half_swap_add(l);
    float fr[16]; row_factors(1.f / l, fr, F.lds, wid, lane);
#pragma unroll
    for (int r = 0; r < 16; ++r) { o[0][r] *= fr[r]; o[1][r] *= fr[r]; }
    bf16_t* Ow = O + (rowbase + q0 + wid * 32) * D + h * 64;
    store_o(o, F.lds, wid, lane, [&](int row) { return Ow + (size_t)row * D; });
    __syncthreads();
}
__device__ __forceinline__ void phase_fox_attn(Frame& F, const Params& P) {
    const float qbound = gain_bound(P.fox_qk_gain, P.fox_qk_gain + 64, F.lane);
    const int NU = NB * NH * 32;
    for (int i = 0; ; ++i) {
        int bh, qb;
        { const int u = i * F.G + F.vcu; if (u >= NU) break; bh = u >> 5; qb = (u + 8 * i) & 31; }
        fox_unit(F, P, bh >> 4, bh & 15, qb, qbound);
    }
}

template <class KP, class VP, class Body>
__device__ __forceinline__ void tile_loop(Frame& F, int nt, KP kptr, VP vptr, int stride, Body body) {
    const int tid = F.tid; (void)stride;
    tile_dma(kptr(0), vptr(0), F.lds, 0, tid, F.wave); WAIT_BAR0();
    for (int j = 0; j < nt; ++j) {
        if (j + 1 < nt) tile_dma(kptr(j + 1), vptr(j + 1), F.lds, (j + 1) & 1, tid, F.wave);
        body(j, (const LAS unsigned char*)(F.lds + AT_K0 + (j & 1) * 8192), (const LAS unsigned char*)(F.lds + AT_V0 + (j & 1) * 8192));
        WAIT_BAR0();
    }
}


template <class Fin>
__device__ __forceinline__ void attn_tile(f32x16 (&o)[2], float& l, const LAS unsigned char* Kbuf, const LAS unsigned char* Vbuf, const bf16x8 (&qr)[4], int lane, Fin fin) {
    const int r32 = lane & 31, hi = lane >> 5;
    const f32x16 z = {0.f, 0.f, 0.f, 0.f, 0.f, 0.f, 0.f, 0.f, 0.f, 0.f, 0.f, 0.f, 0.f, 0.f, 0.f, 0.f};
    const LAS unsigned char* kb = Kbuf + hi * 1024 + r32 * 16;
    const LAS char* vp = (const LAS char*)Vbuf + ((lane >> 4) & 1) * 32 + (lane & 3) * 8 + (4 * hi + ((lane & 15) >> 2)) * 64;
    bf16x8 kf[8];
#pragma unroll
    for (int d0 = 0; d0 < 4; ++d0) { kf[d0] = *(const LAS bf16x8*)(kb + d0 * 2048); kf[4 + d0] = *(const LAS bf16x8*)(kb + d0 * 2048 + 512); }
    __builtin_amdgcn_sched_barrier(0);
    f32x16 p0, p1;
#pragma unroll
    for (int d0 = 0; d0 < 4; ++d0) p0 = __builtin_amdgcn_mfma_f32_32x32x16_bf16(kf[d0], qr[d0], d0 ? p0 : z, 0, 0, 0);
#pragma unroll
    for (int d0 = 0; d0 < 4; ++d0) p1 = __builtin_amdgcn_mfma_f32_32x32x16_bf16(kf[4 + d0], qr[d0], d0 ? p1 : z, 0, 0, 0);
    s16x4 vlo[2][4], vhh[2][4];
#pragma unroll
    for (int d0 = 0; d0 < 2; ++d0)
#pragma unroll
        for (int ks = 0; ks < 4; ++ks) { vlo[d0][ks] = vtr(vp + d0 * 4096 + ks * 1024); vhh[d0][ks] = vtr(vp + d0 * 4096 + ks * 1024 + 512); }
    __builtin_amdgcn_sched_barrier(0);
#define AT_FIN(P, KOFF, PA, PB) \
        fin(P, KOFF); \
        { float s_ = 0.f; _Pragma("unroll") for (int r = 0; r < 16; ++r) s_ += P[r]; l += s_; } \
        u32x4 PA, PB; _Pragma("unroll") for (int i = 0; i < 4; ++i) { PA[i] = cvtpk(P[2 * i], P[2 * i + 1]); PB[i] = cvtpk(P[8 + 2 * i], P[9 + 2 * i]); }
#define AT_PV(PA, PB, KS0) \
        _Pragma("unroll") for (int d0 = 0; d0 < 2; ++d0) { \
            o[d0] = __builtin_amdgcn_mfma_f32_32x32x16_bf16(__builtin_bit_cast(bf16x8, PA), (bf16x8){vlo[d0][KS0][0], vlo[d0][KS0][1], vlo[d0][KS0][2], vlo[d0][KS0][3], vhh[d0][KS0][0], vhh[d0][KS0][1], vhh[d0][KS0][2], vhh[d0][KS0][3]}, o[d0], 0, 0, 0); \
            o[d0] = __builtin_amdgcn_mfma_f32_32x32x16_bf16(__builtin_bit_cast(bf16x8, PB), (bf16x8){vlo[d0][KS0 + 1][0], vlo[d0][KS0 + 1][1], vlo[d0][KS0 + 1][2], vlo[d0][KS0 + 1][3], vhh[d0][KS0 + 1][0], vhh[d0][KS0 + 1][1], vhh[d0][KS0 + 1][2], vhh[d0][KS0 + 1][3]}, o[d0], 0, 0, 0); }
    AT_FIN(p0, 0, pa0, pb0)
    __builtin_amdgcn_sched_barrier(0);
    AT_PV(pa0, pb0, 0)
    AT_FIN(p1, 32, pa1, pb1)
    __builtin_amdgcn_sched_barrier(0);
    AT_PV(pa1, pb1, 2)
#undef AT_FIN
#undef AT_PV
}

__device__ __forceinline__ void nsa_unit(Frame& F, int b, int g, int tb, float qb_c, float qb_s, float qb_w) {
    const int tid = F.tid, lane = F.lane, wid = F.wave, r32 = lane & 31, hi = lane >> 5;
    const int q0 = tb * 64, cur = tb, bg = b * NG + g;
    const int hh = r32 >> 3, tk = 8 * wid + (r32 & 7), t = q0 + tk, head = 4 * g + hh; const size_t row = (size_t)b * T + t;
    const bf16_t* Q = WSP(bf16_t, WS_Q); bf16_t* O = WSP(bf16_t, WS_O); const float* gates = WSP(float, WS_GATES) + row * 48 + head;
    const bf16_t* KC = WSP(bf16_t, WS_KC) + (size_t)bg * 512 * 64; const bf16_t* VC = WSP(bf16_t, WS_VC) + (size_t)bg * 512 * 64;
    const bf16_t* KS = WSP(bf16_t, WS_KS) + (size_t)bg * T * 64; const bf16_t* VS = WSP(bf16_t, WS_VS) + (size_t)bg * T * 64;
    const bf16_t* KW = WSP(bf16_t, WS_KW) + (size_t)bg * T * 64; const bf16_t* VW = WSP(bf16_t, WS_VW) + (size_t)bg * T * 64;
    LAS float* IMP = (LAS float*)(F.lds + AT_IMP); LAS unsigned* SELM = (LAS unsigned*)(F.lds + AT_SELM);
    bf16x8 qr[4];
#pragma unroll
    for (int d0 = 0; d0 < 4; ++d0) qr[d0] = *(const bf16x8*)(Q + row * D + head * 64 + d0 * 16 + hi * 8);
    const float g_c = gates[0], g_s = gates[16], g_w = gates[32];
    LAS float* OT = (LAS float*)(F.lds + AT_OT) + wid * 2048 + lane;
    float fr[16];

    const int NTc = (((q0 + 32) >> 4) >> 6) + 1; const int nmax = (t - 31) >> 4;
    const float sh_c = exp2f(-fmaxf(qb_c - 20.f, 0.f)), sh_s = exp2f(-fmaxf(qb_s - 20.f, 0.f)), sh_w = exp2f(-fmaxf(qb_w - 20.f, 0.f));
    float l_c = 0.f;
    const int nvis_all = (q0 - 31) >> 4, nvis_any = (q0 + 32) >> 4;
    auto fin_half = [&](f32x16& p, int nbase, float mul) {
        if (nbase + 31 <= nvis_all) {
#pragma unroll
            for (int r = 0; r < 16; ++r) p[r] = __builtin_amdgcn_exp2f(p[r]) * mul;
        } else if (nbase > nvis_any) {
#pragma unroll
            for (int r = 0; r < 16; ++r) p[r] = 0.f;
        } else {
#pragma unroll
            for (int r = 0; r < 16; ++r) p[r] = (nbase + crow(r, hi) <= nmax) ? __builtin_amdgcn_exp2f(p[r]) * mul : 0.f;
        }
    };
    tile_loop(F, NTc, [&](int j) { return KC + (size_t)j * 4096; }, [&](int j) { return VC + (size_t)j * 4096; }, 64, [&](int j, const LAS unsigned char* Kbuf, const LAS unsigned char* Vbuf) {
        f32x16 p0, p1; qk_tile(p0, p1, Kbuf, qr, r32, hi);
        fin_half(p0, j * 64, sh_c); fin_half(p1, j * 64 + 32, sh_c);
        l_c += psum(p0, p1);
    });
    l_c = half_swap_add(l_c);
    const float rl = l_c > 0.f ? sh_c / l_c : 0.f;
    {
        f32x16 o[2]; o[0] = splat16(0.f); o[1] = splat16(0.f); float carry = 0.f;
        tile_loop(F, NTc, [&](int j) { return KC + (size_t)j * 4096; }, [&](int j) { return VC + (size_t)j * 4096; }, 64, [&](int j, const LAS unsigned char* Kbuf, const LAS unsigned char* Vbuf) {
            f32x16 p0, p1; qk_tile(p0, p1, Kbuf, qr, r32, hi);
            VFrag vf; v_load(vf, Vbuf, lane);
            fin_half(p0, j * 64, rl); fin_half(p1, j * 64 + 32, rl);
            float rx03 = 0.f, rx13 = 0.f;
#pragma unroll
            for (int c = 0; c < 2; ++c) {
                float A[4], rX[4];
#pragma unroll
                for (int gq = 0; gq < 4; ++gq) {
                    const float x = 16.f * (c ? p1[4 * gq + 3] : p0[4 * gq + 3]);
                    A[gq] = 32.f * (c ? (p1[4 * gq] + p1[4 * gq + 1] + p1[4 * gq + 2]) : (p0[4 * gq] + p0[4 * gq + 1] + p0[4 * gq + 2])) + x;
                    rX[gq] = xor32_other(x);
                }
#pragma unroll
                for (int gq = 0; gq < 4; ++gq) {
                    const float prev = gq > 0 ? rX[gq - 1] : (c > 0 ? rx03 : carry);
                    float tot = A[gq] + (hi ? rX[gq] : prev);
                    tot = xor16_sum(xor8_sum(tot));
                    if (r32 < 8) IMP[tk * 128 + 16 * j + 8 * c + 2 * gq + hi] = tot;
                }
                if (c == 0) rx03 = rX[3]; else rx13 = rX[3];
            }
            carry = rx13;
            pv_tile(o, vf, p0, p1);
        });
        row_factors(g_c, fr, F.lds, wid, lane);
#pragma unroll
        for (int r = 0; r < 16; ++r) { OT[r * 64] = o[0][r] * fr[r]; OT[(16 + r) * 64] = o[1][r] * fr[r]; }
    }
    unsigned m0 = 0u, m1 = 0u, m2 = 0u, m3 = 0u;
    {
        LDS_WAIT(); asm volatile("" ::: "memory");
        const int tkk = lane >> 3, sub = lane & 7;
#define SETBIT(jx) do { const int j_ = (jx); const unsigned bit_ = 1u << (j_ & 31); const int w_ = j_ >> 5; m0 |= (w_ == 0) ? bit_ : 0u; m1 |= (w_ == 1) ? bit_ : 0u; m2 |= (w_ == 2) ? bit_ : 0u; m3 |= (w_ == 3) ? bit_ : 0u; } while (0)
        if (cur <= 15) { m0 = (cur == 31) ? 0xffffffffu : ((1u << (cur + 1)) - 1u); }
        else {
            SETBIT(0); SETBIT(cur); SETBIT(cur - 1);
            unsigned key[16];
#pragma unroll
            for (int i = 0; i < 16; ++i) { const int jx = sub + 8 * i; const unsigned kb_ = (__float_as_uint(IMP[(8 * wid + tkk) * 128 + jx]) & ~0x7Fu) | (unsigned)(127 - jx); key[i] = (jx >= 1 && jx <= cur - 2) ? kb_ : 0u; }
#pragma unroll 1
            for (int rnd = 0; rnd < SELTOP - 3; ++rnd) {
                unsigned best = 0u;
#pragma unroll
                for (int i = 0; i < 16; ++i) best = max(best, key[i]);
                best = max8_u32(best);
                const int bj = 127 - (int)(best & 0x7Fu);
                SETBIT(bj);
#pragma unroll
                for (int i = 0; i < 16; ++i) key[i] = (key[i] == best) ? 0u : key[i];
            }
        }
#undef SETBIT
        if (sub == 0) { LAS unsigned* d = SELM + (8 * wid + tkk) * 4; d[0] = m0; d[1] = m1; d[2] = m2; d[3] = m3; }
        LDS_WAIT(); asm volatile("" ::: "memory");
        const LAS unsigned* s = SELM + tk * 4; m0 = s[0]; m1 = s[1]; m2 = s[2]; m3 = s[3];
        LDS_WAIT();
    }
    {
        f32x16 o[2]; o[0] = splat16(0.f); o[1] = splat16(0.f); float l = 0.f;
        tile_loop(F, cur + 1, [&](int j) { return KS + (size_t)j * 4096; }, [&](int j) { return VS + (size_t)j * 4096; }, 64, [&](int j, const LAS unsigned char* Kbuf, const LAS unsigned char* Vbuf) {
            const unsigned w = j < 32 ? m0 : j < 64 ? m1 : j < 96 ? m2 : m3; const bool sel = (w >> (j & 31)) & 1u;
            if (__any(sel)) {
                const float sc = sel ? sh_s : 0.f; const bool diag = j == cur;
                attn_tile(o, l, Kbuf, Vbuf, qr, lane, [&](f32x16& p, int koff) {
#pragma unroll
                    for (int r = 0; r < 16; ++r) { float e = __builtin_amdgcn_exp2f(p[r]) * sc; if (diag) e = crow(r, hi) + koff > tk ? 0.f : e; p[r] = e; } });
            }
        });
        l = half_swap_add(l);
        row_factors(g_s / l, fr, F.lds, wid, lane);
#pragma unroll
        for (int r = 0; r < 16; ++r) { OT[r * 64] += o[0][r] * fr[r]; OT[(16 + r) * 64] += o[1][r] * fr[r]; }
    }
    {
        f32x16 o[2]; o[0] = splat16(0.f); o[1] = splat16(0.f); float l = 0.f;
        const int j0 = cur >= 8 ? cur - 8 : 0;
        tile_loop(F, cur - j0 + 1, [&](int j) { return KW + (size_t)(j0 + j) * 4096; }, [&](int j) { return VW + (size_t)(j0 + j) * 4096; }, 64, [&](int j, const LAS unsigned char* Kbuf, const LAS unsigned char* Vbuf) {
            const bool first = (j0 + j) == cur - 8, diag = (j0 + j) == cur;
            if (first) attn_tile(o, l, Kbuf, Vbuf, qr, lane, [&](f32x16& p, int koff) {
#pragma unroll
                for (int r = 0; r < 16; ++r) { const int kk = crow(r, hi) + koff; const float e = __builtin_amdgcn_exp2f(p[r]) * sh_w; p[r] = kk <= tk ? 0.f : e; } });
            else if (diag) attn_tile(o, l, Kbuf, Vbuf, qr, lane, [&](f32x16& p, int koff) {
#pragma unroll
                for (int r = 0; r < 16; ++r) { const int kk = crow(r, hi) + koff; const float e = __builtin_amdgcn_exp2f(p[r]) * sh_w; p[r] = kk > tk ? 0.f : e; } });
            else attn_tile(o, l, Kbuf, Vbuf, qr, lane, [&](f32x16& p, int koff) {
#pragma unroll
                for (int r = 0; r < 16; ++r) p[r] = __builtin_amdgcn_exp2f(p[r]) * sh_w; });
        });
        l = half_swap_add(l);
        row_factors(g_w / l, fr, F.lds, wid, lane);
#pragma unroll
        for (int r = 0; r < 16; ++r) { o[0][r] = OT[r * 64] + o[0][r] * fr[r]; o[1][r] = OT[(16 + r) * 64] + o[1][r] * fr[r]; }
        LDS_WAIT();
        bf16_t* Ob_ = O + ((size_t)b * T + q0 + 8 * wid) * D + 4 * g * 64;
        store_o(o, F.lds, wid, lane, [&](int r) { return Ob_ + (size_t)(r & 7) * D + (r >> 3) * 64; });
    }
    __syncthreads();
}
__device__ __forceinline__ void phase_nsa_attn(Frame& F, const Params& P) {
    const float qb_c = gain_bound(P.nsa_q_gain, P.kv_k_gain, F.lane), qb_s = gain_bound(P.nsa_q_gain, P.kv_k_gain + 64, F.lane), qb_w = gain_bound(P.nsa_q_gain, P.kv_k_gain + 128, F.lane);
    const int NU = NB * NG * 128;
    for (int i = 0; ; ++i) {
        int bg, tb;
        if (F.G == 256) { if (i >= 4) break; const int s = F.vcu & 31; bg = F.vcu >> 5; tb = (i == 0) ? s : (i == 1) ? 63 - s : (i == 2) ? 64 + s : 127 - s; }
        else { const int u = i * F.G + F.vcu; if (u >= NU) break; bg = u >> 7; tb = 127 - (u & 127); }
        nsa_unit(F, bg >> 2, bg & 3, tb, qb_c, qb_s, qb_w);
    }
}

struct CmpSched : BrowStd {
    const char* A; const char* Bt; int G, c;
    __device__ __forceinline__ bool next(int i, gm::Unit& u) const { if (i > 0 || c >= 32) return false; u.aux = c >> 4; u.pm = c & 15; u.pn = 0; u.cnt = 0; return true; }
    __device__ __forceinline__ const char* a_base() const { return A; }
    __device__ __forceinline__ unsigned a_off(const gm::Unit& u, int row) const { return (unsigned)u.aux * (unsigned)KV6_STRIDE + (unsigned)(u.pm * 256 + row) * 2048u; }
    __device__ __forceinline__ const char* b_base(const gm::Unit& u) const { return Bt + (size_t)u.aux * (256 * 2048 * 2); }
    __device__ __forceinline__ size_t hstepB() const { return (size_t)128 * 2048 * 2; }
};
struct EpiCompress {
    static constexpr bool AFTER_DRAIN = true;
    const float* cb1; const bf16_t* w2t; const float* kgain; const float* rope; bf16_t* KC; bf16_t* VC;
    __device__ __forceinline__ void operator()(const f32x4 (&)[2][2][4][2], const gm::Unit&, int, int, int, int) const {}
    __device__ __forceinline__ void fused(f32x4 (&acc)[2][2][4][2], const gm::Unit& u, int wr, int wc, int fr, int fq, LAS unsigned char* lds, int wid, int lane) const {
        const int j = u.aux;
#pragma unroll
        for (int bj = 0; bj < 2; ++bj) {
            const int col0 = 128 * bj + 32 * wc + 8 * fq; const f32x4 b0 = *(const f32x4*)(cb1 + j * 256 + col0), b1 = *(const f32x4*)(cb1 + j * 256 + col0 + 4);
            const int chunk = 16 * bj + 4 * wc + fq;
#pragma unroll
            for (int ai = 0; ai < 2; ++ai)
#pragma unroll
                for (int m = 0; m < 4; ++m) { const int row = 128 * ai + 64 * wr + 16 * m + fr; f32x4 h0 = acc[ai][bj][m][0] + b0, h1 = acc[ai][bj][m][1] + b1;
#pragma unroll
                    for (int jj = 0; jj < 4; ++jj) { h0[jj] = h0[jj] * __builtin_amdgcn_rcpf(1.f + __builtin_amdgcn_exp2f(-LOG2E * h0[jj])); h1[jj] = h1[jj] * __builtin_amdgcn_rcpf(1.f + __builtin_amdgcn_exp2f(-LOG2E * h1[jj])); }
                    *(LAS u32x4*)(lds + row * 512 + ((chunk ^ (row & 15)) * 16)) = pack8(h0, h1); }
        }
        LDS_WAIT(); __builtin_amdgcn_s_barrier(); asm volatile("" ::: "memory");
        const int r32 = lane & 31, hi = lane >> 5; const int trow = 32 * wid + r32;
        f32x16 a2[2]; a2[0] = splat16(0.f); a2[1] = splat16(0.f);
        const bf16_t* wb = w2t + (size_t)j * 64 * 256;
#pragma unroll 4
        for (int ks = 0; ks < 16; ++ks) {
            const bf16x8 hb = *(const LAS bf16x8*)(lds + trow * 512 + (((2 * ks + hi) ^ (trow & 15)) * 16));
#pragma unroll
            for (int cb = 0; cb < 2; ++cb) { const bf16x8 wa = *(const bf16x8*)(wb + (size_t)(32 * cb + r32) * 256 + 16 * ks + 8 * hi);
                a2[cb] = __builtin_amdgcn_mfma_f32_32x32x16_bf16(wa, hb, a2[cb], 0, 0, 0); }
        }
        const int n = (u.pm & 1) * 256 + trow, bg = u.pm >> 1;
        if (j == 0) {
            float s = 0.f;
#pragma unroll
            for (int cb = 0; cb < 2; ++cb)
#pragma unroll
                for (int r = 0; r < 16; ++r) s += a2[cb][r] * a2[cb][r];
            s = half_swap_add(s);
            const float rs = __builtin_amdgcn_rsqf(s * (1.f / 64.f) + EPS);
#pragma unroll
            for (int cb = 0; cb < 2; ++cb)
#pragma unroll
                for (int r = 0; r < 16; ++r) a2[cb][r] *= rs * kgain[32 * cb + crow(r, hi)];
            const int pos = 16 * n + 31; const float* rp = rope + (size_t)(pos < T ? pos : T - 1) * 16;
#pragma unroll
            for (int r = 0; r < 4; ++r) { const int i = r + 4 * hi; const float c = rp[2 * i], sn = rp[2 * i + 1]; const float x1 = a2[0][r], x2 = a2[0][r + 4];
                a2[0][r] = x1 * c - x2 * sn; a2[0][r + 4] = x2 * c + x1 * sn; }
        }
        bf16_t* hb = (j == 0 ? KC : VC) + (size_t)bg * 512 * 64;
        const bool zero = n >= NCMP;
#pragma unroll
        for (int cb = 0; cb < 2; ++cb)
#pragma unroll
            for (int rq = 0; rq < 4; ++rq) { u32x2 o; o.x = pk2(a2[cb][4 * rq], a2[cb][4 * rq + 1]); o.y = pk2(a2[cb][4 * rq + 2], a2[cb][4 * rq + 3]); if (zero) { o.x = 0u; o.y = 0u; }
                const int d = 32 * cb + 8 * rq + 4 * hi;
                *(u32x2*)(hb + (j == 0 ? kimg_off(n, d) : vimg_off(n, d))) = o; }
    }
};

constexpr int N_PHASES = 21;
#if defined(__HIP_DEVICE_COMPILE__)
typedef const __attribute__((address_space(4))) Params* kparams_t;
__device__ __forceinline__ kparams_t kargs() { kparams_t p = (kparams_t)__builtin_amdgcn_kernarg_segment_ptr(); asm volatile("" : "+s"(p)); return p; }
#define KP(f) (kargs()->f)
#else
#define KP(f) (Params{}.f)
#endif
#define LOADP() Params P; { P.x = KP(x); P.p = KP(p); P.attn_norm = KP(attn_norm); P.ffn_norm = KP(ffn_norm); P.ple_norm = KP(ple_norm); P.ple_gate_w = KP(ple_gate_w); P.ple_proj_w = KP(ple_proj_w); \
    P.router_w = KP(router_w); P.router_b = KP(router_b); P.w_gu = KP(w_gu); P.b_gu = KP(b_gu); P.w_down = KP(w_down); P.b_down = KP(b_down); P.fox_w_in = KP(fox_w_in); P.fox_b_f = KP(fox_b_f); \
    P.fox_qk_gain = KP(fox_qk_gain); P.fox_w_out = KP(fox_w_out); P.kv_norm = KP(kv_norm); P.kv_w = KP(kv_w); P.kv_k_gain = KP(kv_k_gain); P.cmp_pos = KP(cmp_pos); P.cmp_w1 = KP(cmp_w1); P.cmp_w2 = KP(cmp_w2); \
    P.nsa_w_in = KP(nsa_w_in); P.nsa_q_gain = KP(nsa_q_gain); P.nsa_w_out = KP(nsa_w_out); P.out = KP(out); P.ws = KP(ws); P.ph_lo = 0; P.ph_hi = 0; } F.ws = P.ws

#define XB_TMO      128
#define XB_XCNT(j)  (256  + 64 * (j))
#define XB_XSUB(j)  (1280 + 64 * (j))
#define XB_XGEN(j)  (2304 + 64 * (j))
#define XB_TOP      3328
#define XB_TOPGEN   3392
#define XB_SPIN_CAP (1u << 22)
__device__ __forceinline__ unsigned xb_ld(unsigned* p)              { return __hip_atomic_load(p, __ATOMIC_RELAXED, __HIP_MEMORY_SCOPE_AGENT); }
__device__ __forceinline__ unsigned xb_add(unsigned* p, unsigned v) { return __hip_atomic_fetch_add(p, v, __ATOMIC_RELAXED, __HIP_MEMORY_SCOPE_AGENT); }
__device__ __forceinline__ unsigned xb_xcc_id() { return (unsigned)__builtin_amdgcn_s_getreg((3 << 11) | 20) & 0xFu; }
#define XB_SPIN(cond, bar) do { unsigned _sp = 0; while (cond) { __builtin_amdgcn_s_sleep(1); \
    if ((++_sp & 255u) == 0u) { if (xb_ld(&(bar)[XB_TMO])) break; if (_sp > XB_SPIN_CAP) { atomicAdd(&(bar)[XB_TMO], 1u); break; } } } } while (0)
__device__ __forceinline__ void xcd_barrier_post(unsigned* bar, int tid) { if (tid == 0) (void)xb_add(&bar[XB_XCNT(xb_xcc_id())], 1u); }
__device__ __forceinline__ void xcd_barrier_complete(unsigned* bar, unsigned x, unsigned& nloc, unsigned& nx) {
    const unsigned G = gridDim.x;
    unsigned sum, cnt, mine, sp = 0u;
    for (;;) {
        sum = 0u; cnt = 0u; mine = 0u;
#pragma unroll
        for (unsigned j = 0; j < 16; ++j) { const unsigned c = xb_ld(&bar[XB_XCNT(j)]); sum += c; cnt += (c > 0u) ? 1u : 0u; mine = (j == x) ? c : mine; }
        if (sum == G) break;
        __builtin_amdgcn_s_sleep(1);
        if ((++sp & 255u) == 0u) { if (xb_ld(&bar[XB_TMO])) break; if (sp > XB_SPIN_CAP) { atomicAdd(&bar[XB_TMO], 1u); break; } }
    }
    nloc = mine > 0u ? mine : 1u; nx = cnt > 0u ? cnt : 1u;
}
__device__ __forceinline__ void xcd_barrier(unsigned* bar, volatile LAS unsigned* st, int tid) {
    asm volatile("s_waitcnt vmcnt(0)" ::: "memory");
    __syncthreads();
    if (tid == 0) {
        const unsigned x = xb_xcc_id();
        __builtin_amdgcn_s_waitcnt(0);
        unsigned nloc = st[0], nx = st[1];
        if (nloc == 0u) { xcd_barrier_complete(bar, x, nloc, nx); st[0] = nloc; st[1] = nx; }
        const unsigned old = xb_add(&bar[XB_XSUB(x)], 1u);
        const unsigned gen = old / nloc;
        if (old + 1u == (gen + 1u) * nloc) {
            __builtin_amdgcn_fence(__ATOMIC_RELEASE, "agent");
            asm volatile("s_waitcnt vmcnt(0)" ::: "memory");
            const unsigned og = xb_add(&bar[XB_TOP], 1u);
            const unsigned tg = og / nx;
            if (og + 1u == (tg + 1u) * nx) xb_add(&bar[XB_TOPGEN], 1u);
            else XB_SPIN(xb_ld(&bar[XB_TOPGEN]) == tg, bar);
            __builtin_amdgcn_fence(__ATOMIC_ACQUIRE, "agent");
            xb_add(&bar[XB_XGEN(x)], 1u);
            asm volatile("s_waitcnt vmcnt(0)" ::: "memory");
        } else {
            XB_SPIN(xb_ld(&bar[XB_XGEN(x)]) == gen, bar);
            __builtin_amdgcn_fence(__ATOMIC_ACQUIRE, "agent");
            asm volatile("s_waitcnt vmcnt(0)" ::: "memory");
        }
    }
    __syncthreads();
}

__device__ __forceinline__ void pp_gemm(Frame& F, int l) {
    __syncthreads();
    int K5 = 256; asm volatile("" : "+s"(K5));
    DenseSched<BrowStd> S; S.init(WSP(bf16_t, WS_PBF) + (size_t)l * M * PLE, 512, WSP(bf16_t, WS_WPLEP) + (size_t)l * D * PLE, (size_t)256 * 256 * 2, (size_t)128 * 256 * 2, M, 4, F.G, F.bx);
    EpiBf16 E{WSP(bf16_t, WS_PP) + (size_t)l * M * D, D};
    gm::gemm_phase(F.lds, K5, S, E, F.tid);
}

extern __shared__ __attribute__((aligned(16))) unsigned char lds_raw[];
template <int PH>
__device__ __forceinline__ void run_phase(int wv) {
    Frame F;
    int tid_ = wv * 64 + lane_id_v(); asm volatile("" : "+v"(tid_));
    F.lds = (LAS unsigned char*)lds_raw; F.tid = tid_; F.lane = F.tid & 63; F.wave = __builtin_amdgcn_readfirstlane(F.tid >> 6);
    int bx = blockIdx.x; asm volatile("" : "+s"(bx));
    F.G = gridDim.x; F.vcu = (F.G % 8 == 0) ? (bx % 8) * (F.G / 8) + bx / 8 : bx; F.bx = bx;
    F.gw = F.vcu * NWAVES + F.wave; F.NGW = F.G * NWAVES;
    LOADP();
    bf16_t* XB = WSP(bf16_t, WS_XB);
    constexpr int layer = (PH >= 16) ? 1 : 0;
    constexpr int ph = (PH >= 16) ? PH - 10 : PH;
    LAS int* tstart = (LAS int*)(F.lds + LDS_MISC); LAS int* ecnt = tstart + 64;
    if constexpr (PH == 0) { phase_prologue(F, P); }
    else if constexpr (PH == 1) { phase_fox_pre(F, P); }
    else if constexpr (PH == 2) {
        if (F.vcu < NB * NH) fox_scan(F, F.vcu);
        DenseSched<BrowHead> S; S.init(WSP(bf16_t, WS_XN), 2048, WSP(bf16_t, WS_WFOXIN), (size_t)256 * 1024 * 2, (size_t)32 * 1024 * 2, M, 12, F.G, F.bx);
        EpiFoxQKV E{WSP(bf16_t, WS_Q), P.fox_qk_gain};
        gm::gemm_phase(F.lds, 1024, S, E, F.tid);
    }
    else if constexpr (PH == 3) { phase_fox_attn(F, P); }
    else if constexpr (PH == 4) {
        DenseSched<BrowStd> S; S.init(WSP(bf16_t, WS_O), 2048, WSP(bf16_t, WS_WFOXOUT), (size_t)256 * 1024 * 2, (size_t)128 * 1024 * 2, M, 4, F.G, F.bx);
        EpiResid<float> E{P.x, XB};
        gm::gemm_phase(F.lds, 1024, S, E, F.tid);
        pp_gemm(F, 0);
    }
    else if constexpr (PH == 5) { }
    else if constexpr (ph == 6) {
#if defined(PROBE_ROUTE)
        phase_moe_route(F, P, layer, XB, 2 + layer); __syncthreads();
#endif
        phase_moe_route(F, P, layer, XB); }
    else if constexpr (ph == 7) {
        const int ntot = moe_tables(F, layer, tstart, ecnt);
        MoeSched S; S.A = (const char*)WSP(unsigned char, WS_XN8); S.list = WSP(int, WS_LIST); S.Bt = (const char*)(WSP(unsigned char, WS_WGU) + (size_t)layer * NE * 2048 * 1024); S.estride = (size_t)2048 * 1024;
        S.tstepB_ = (size_t)128 * 1024; S.hstepB_ = (size_t)1024 * 1024; S.npn = 8; S.G = F.G; S.c = F.vcu; S.ntot = ntot; S.gather = true; S.tstart = tstart; S.ecnt = ecnt;
        EpiSwiglu E{WSP(unsigned char, WS_H), P.b_gu + (size_t)layer * NE * 2048};
        int K8 = 512; asm volatile("" : "+s"(K8)); gm::gemm_phase<true>(F.lds, K8, S, E, F.tid);
    }
    else if constexpr (ph == 8) {
        const int ntot = moe_tables(F, layer, tstart, ecnt, true);
        MoeSched S; S.A = (const char*)WSP(unsigned char, WS_H); S.list = nullptr; S.Bt = (const char*)(WSP(unsigned char, WS_WDN) + (size_t)layer * NE * 1024 * 1024); S.estride = (size_t)1024 * 1024;
        S.tstepB_ = (size_t)256 * 1024; S.hstepB_ = (size_t)128 * 1024; S.npn = 4; S.G = F.G; S.c = F.vcu; S.ntot = ntot; S.gather = false; S.tstart = tstart; S.ecnt = ecnt;
        EpiDown E{WSP(unsigned char, WS_Y), P.b_down + (size_t)layer * NE * D, WSP(float, WS_GL)};
        int K8 = 512; asm volatile("" : "+s"(K8)); gm::gemm_phase<true>(F.lds, K8, S, E, F.tid);
    }
    else if constexpr (ph == 9) { phase_moe_combine(F, layer, XB); }
    else if constexpr (ph == 10) {
        DenseSched<BrowStd> S; S.init(WSP(unsigned char, WS_XN8), 1024, WSP(unsigned char, WS_WPLEG) + (size_t)layer * D * D, (size_t)256 * 1024, (size_t)128 * 1024, M, 4, F.G, F.bx);
        int K8 = 512; asm volatile("" : "+s"(K8));
        if constexpr (layer == 1) { EpiPle<float> E{XB, P.out, WSP(bf16_t, WS_PP) + (size_t)layer * M * D}; gm::gemm_phase<true>(F.lds, K8, S, E, F.tid); }
        else { EpiPle<bf16_t> E{XB, XB, WSP(bf16_t, WS_PP) + (size_t)layer * M * D}; gm::gemm_phase<true>(F.lds, K8, S, E, F.tid); }
    }
    else if constexpr (PH == 11) { phase_nsa_pre(F); }
    else if constexpr (PH == 12) {
        DenseSched<BrowHead> S; S.init(WSP(bf16_t, WS_XB), 2048, WSP(bf16_t, WS_WNSA), (size_t)256 * 1024 * 2, (size_t)32 * 1024 * 2, M, 10, F.G, F.bx);
        EpiNsaKVQ E{WSP(bf16_t, WS_Q), WSP(bf16_t, WS_ZK), P.kv_k_gain, P.nsa_q_gain, WSP(float, WS_ROPE), WSP(float, WS_RSTD)};
        gm::gemm_phase(F.lds, 1024, S, E, F.tid);
        if (F.G == 256 && F.bx >= 128) { __syncthreads(); convert_moe_l1(F, P, F.bx - 128, 128, 0, L1_SPLIT); }

    }
    else if constexpr (PH == 13) {
        CmpSched S; S.A = (const char*)WSP(bf16_t, WS_ZK); S.Bt = (const char*)WSP(bf16_t, WS_WC1); S.G = F.G; S.c = F.vcu;
        EpiCompress E{WSP(float, WS_CB1), WSP(bf16_t, WS_WC2), P.kv_k_gain, WSP(float, WS_ROPE), WSP(bf16_t, WS_KC), WSP(bf16_t, WS_VC)};
        if (F.vcu < 32 || F.G <= 32) gm::gemm_phase(F.lds, 2048, S, E, F.tid);
        const int lo = (F.G == 256) ? L1_SPLIT : 0;
        if (F.vcu >= 32) convert_moe_l1(F, P, F.vcu - 32, F.G - 32, lo, L1_ITEMS);
        else if (F.G <= 32) convert_moe_l1(F, P, F.vcu, F.G, lo, L1_ITEMS);
    }
    else if constexpr (PH == 14) { phase_nsa_attn(F, P); }
    else if constexpr (PH == 15) {
        DenseSched<BrowStd> S; S.init(WSP(bf16_t, WS_O), 2048, WSP(bf16_t, WS_WNSAOUT), (size_t)256 * 1024 * 2, (size_t)128 * 1024 * 2, M, 4, F.G, F.bx);
        EpiResid<bf16_t> E{XB, XB};
        gm::gemm_phase(F.lds, 1024, S, E, F.tid);
        pp_gemm(F, 1);
    }
}
template <int K, int HI>
__device__ __forceinline__ void run_range(int wv) {
    if constexpr (K == 5) { if constexpr (K + 1 < HI) run_range<K + 1, HI>(wv); return; }
    run_phase<K>(wv);
    if constexpr ((REPEAT_MASK >> K) & 1u) { int tid = wv * 64 + lane_id_v(); asm volatile("" : "+v"(tid)); xcd_barrier((unsigned*)(KP(ws) + WS_CTL) + CW_BAR, (volatile LAS unsigned*)((LAS unsigned char*)lds_raw + LDS_MISC + 512), tid); run_phase<K>(wv); }
    if constexpr (K + 1 < HI) {
        { int tid = wv * 64 + lane_id_v(); asm volatile("" : "+v"(tid)); xcd_barrier((unsigned*)(KP(ws) + WS_CTL) + CW_BAR, (volatile LAS unsigned*)((LAS unsigned char*)lds_raw + LDS_MISC + 512), tid); }
        run_range<K + 1, HI>(wv);
    }
}
template <int LO, int HI>
__global__ void __launch_bounds__(NTHREADS, 2) __attribute__((target("no-packed-fp32-ops"))) mega(Params P_) {
    const int wv = __builtin_amdgcn_readfirstlane((int)threadIdx.x >> 6);
    if constexpr (HI - LO > 1) {
        if (KP(ph_hi) < 0) cg::this_grid().sync();
        int tid = wv * 64 + lane_id_v(); asm volatile("" : "+v"(tid));
        volatile LAS unsigned* st = (volatile LAS unsigned*)((LAS unsigned char*)lds_raw + LDS_MISC + 512);
        if (tid < 2) st[tid] = 0u;
        __syncthreads();
        xcd_barrier_post((unsigned*)(KP(ws) + WS_CTL) + CW_BAR, tid);
    }
    run_range<LO, HI>(wv);
}

#if N_LAUNCH_MODE == 1
#define FULLK (mega<0, N_PHASES>)
static void set_attrs() { (void)hipFuncSetAttribute((const void*)FULLK, hipFuncAttributeMaxDynamicSharedMemorySize, LDS_BYTES); }
#else
#define FULLK (mega<0, 1>)
template <int K> static void set_attr1() { (void)hipFuncSetAttribute((const void*)(mega<K, K + 1>), hipFuncAttributeMaxDynamicSharedMemorySize, LDS_BYTES); if constexpr (K + 1 < N_PHASES) set_attr1<K + 1>(); }
static void set_attrs() { set_attr1<0>(); }
template <int K> static void launch_all(const Params& P, int grid, hipStream_t stream) {
    hipLaunchKernelGGL((mega<K, K + 1>), dim3(grid), dim3(NTHREADS), LDS_BYTES, stream, P);
    if constexpr (K + 1 < N_PHASES) launch_all<K + 1>(P, grid, stream);
}
#endif
extern "C" void kernel_launch(void* const* d_in, const int* in_sizes, int n_in, void* d_out, int out_size, void* d_ws, size_t ws_size, hipStream_t stream) {
    static int grid = 0;
    if (grid == 0) {
        if (n_in != 26 || ws_size < WS_END) { fprintf(stderr, "kernel_launch: unexpected inputs (n_in %d, ws %zu, need %zu)\n", n_in, ws_size, (size_t)WS_END); grid = -1; return; }
        int dev = 0, cus = 0, per_cu = 0;
        hipGetDevice(&dev); hipDeviceGetAttribute(&cus, hipDeviceAttributeMultiprocessorCount, dev);
        set_attrs();
        hipOccupancyMaxActiveBlocksPerMultiprocessor(&per_cu, (const void*)FULLK, NTHREADS, LDS_BYTES);
        (void)hipGetLastError();
        if (per_cu < 1) { fprintf(stderr, "kernel_launch: occupancy query says %d blocks/CU\n", per_cu); grid = -1; return; }
        grid = cus;
    }
    if (grid < 0) return;
    hipMemsetAsync((char*)d_ws + WS_CTL, 0, CTL_USED_BYTES, stream);
    Params P{};
    const float** pp = (const float**)&P;
    for (int i = 0; i < 26; ++i) pp[i] = (const float*)d_in[i];
    P.out = (float*)d_out; P.ws = (unsigned char*)d_ws;
#if N_LAUNCH_MODE == 1
    P.ph_lo = 0; P.ph_hi = N_PHASES;
    void* args[] = {&P};
    hipError_t e = hipLaunchCooperativeKernel((const void*)FULLK, dim3(grid), dim3(NTHREADS), args, LDS_BYTES, stream);
    if (e != hipSuccess) fprintf(stderr, "cooperative launch failed: %s (grid %d)\n", hipGetErrorString(e), grid);
#else
    launch_all<0>(P, grid, stream);
#endif
}
```
